# Optimizing an MI355X kernel written in HIP

```python
import math
import jax, jax.numpy as jnp
from jax import lax
import numpy as np

D_MODEL = 2048
BATCH = 2
SEQ = 4096
DEPTH = 2
DEC_BATCH = 32
DEC_SEQ = 64
PAST_LEN = 2048

CHUNK = 64
QBLOCK = 128
ML_HEADS = 4
ML_QK_DIM = 128
ML_V_DIM = 256
DA_HEADS = 4
DA_HEAD_DIM = 128
DA_V_DIM = 2 * DA_HEAD_DIM
CONV_W = 4
D_FF = 5504
EPS = 1e-6

ML_WIDTH = ML_HEADS * ML_V_DIM
DA_WIDTH = DA_HEADS * DA_V_DIM
MIX_WIDTH = ML_WIDTH + DA_WIDTH
ML_CONV_CH = 2 * ML_HEADS * ML_QK_DIM
DA_QK_WIDTH = DA_HEADS * 2 * DA_HEAD_DIM
IN_SIZES = (ML_CONV_CH, ML_WIDTH, ML_WIDTH, ML_HEADS, ML_HEADS, DA_QK_WIDTH, DA_QK_WIDTH, DA_WIDTH)
SPLIT_IDX = tuple(int(s) for s in np.cumsum(IN_SIZES)[:-1])
N_IN = int(sum(IN_SIZES))

kernel_name = "hybrid_mlstm_diffattn_streaming_step"


def rmsnorm(x, g):
    xf = x.astype(jnp.float32)
    y = xf * lax.rsqrt(jnp.mean(xf * xf, axis=-1, keepdims=True) + EPS)
    return (y * g.astype(jnp.float32)).astype(x.dtype)


def swiglu(x, wg, wu, wd):
    return (jax.nn.silu(x @ wg) * (x @ wu)) @ wd


def causal_conv(x, buf, w, b):
    L = x.shape[1]
    xp = jnp.concatenate([buf.astype(x.dtype), x], axis=1)
    y = b + xp[:, 0:L] * w[0]
    for j in range(1, CONV_W):
        y = y + xp[:, j:j + L] * w[j]
    return y, xp[:, -(CONV_W - 1):]


def mlstm_block(carry, xs):
    C, n, m = carry
    q, k, v, ig, lf = xs
    L = q.shape[2]
    b = jnp.cumsum(lf, axis=-1)
    causal = jnp.tril(jnp.ones((L, L), dtype=bool))
    d = jnp.where(causal, b[..., :, None] - b[..., None, :] + ig[..., None, :], -jnp.inf)
    inter = b + m[..., None]
    m_t = jnp.maximum(inter, jnp.max(d, axis=-1))
    w_intra = jnp.exp(d - m_t[..., None])
    w_inter = jnp.exp(inter - m_t)
    s = jnp.einsum("bhtd,bhsd->bhts", q, k) * w_intra
    num = jnp.einsum("bhts,bhsv->bhtv", s, v) + w_inter[..., None] * jnp.einsum("bhvd,bhtd->bhtv", C, q)
    den = jnp.sum(s, axis=-1) + w_inter * jnp.einsum("bhd,bhtd->bht", n, q)
    h = num / jnp.maximum(jnp.abs(den), jnp.exp(-m_t))[..., None]
    m_new = m_t[..., -1]
    w_state = jnp.exp(b[..., -1:] - b + ig - m_new[..., None])
    decay = jnp.exp(b[..., -1] + m - m_new)
    C_new = decay[..., None, None] * C + jnp.einsum("bhs,bhsv,bhsd->bhvd", w_state, v, k)
    n_new = decay[..., None] * n + jnp.einsum("bhs,bhsd->bhd", w_state, k)
    return (C_new, n_new, m_new), h


def mlstm_scan(q, k, v, ig, lf, C, n, m, block):
    B, H, S = q.shape[:3]
    nb = S // block

    def to_blocks(a):
        a = a.reshape(a.shape[:2] + (nb, block) + a.shape[3:])
        return jnp.moveaxis(a, 2, 0)

    (C, n, m), hs = lax.scan(mlstm_block, (C, n, m), tuple(to_blocks(a) for a in (q, k, v, ig, lf)))
    hs = jnp.moveaxis(hs, 0, 2).reshape(B, H, S, ML_V_DIM)
    return hs, (C, n, m)


def diff_attn_block(q, k, v, q_pos, k_pos, lam):
    scale = DA_HEAD_DIM ** -0.5
    q1, q2 = jnp.split(q, 2, axis=-1)
    k1, k2 = jnp.split(k, 2, axis=-1)
    mask = (q_pos // CHUNK)[:, None] >= (k_pos // CHUNK)[None, :]

    def probs(qa, ka):
        sc = jnp.einsum("bqhd,bkhd->bhqk", qa, ka) * scale
        return jax.nn.softmax(jnp.where(mask, sc, -jnp.inf), axis=-1)

    a = probs(q1, k1) - lam * probs(q2, k2)
    return jnp.einsum("bhqk,bkhv->bqhv", a, v)


def diff_attn_prompt(q, k, v, lam):
    B, S = q.shape[:2]
    nb = S // QBLOCK
    qb = jnp.moveaxis(q.reshape(B, nb, QBLOCK, DA_HEADS, 2 * DA_HEAD_DIM), 1, 0)
    pos = jnp.arange(S)
    qpos = pos.reshape(nb, QBLOCK)
    out = lax.map(lambda a: diff_attn_block(a[0], k, v, a[1], pos, lam), (qb, qpos))
    return jnp.moveaxis(out, 0, 1).reshape(B, S, DA_HEADS, DA_V_DIM)


def mixer(hn, w_in, b_i, b_f, conv_w, conv_b, ml_g, lq1, lk1, lq2, lk2, da_g, w_out,
          lam_init, conv_buf, C, n, m, k_cache, v_cache):
    B, L, _ = hn.shape
    dt = hn.dtype
    f32 = jnp.float32
    qk_raw, ml_v, ml_o, ml_i, ml_f, da_q, da_k, da_v = jnp.split(hn @ w_in, SPLIT_IDX, axis=-1)
    qk, conv_new = causal_conv(qk_raw, conv_buf, conv_w, conv_b)
    ml_q, ml_k = jnp.split(jax.nn.silu(qk), 2, axis=-1)

    def heads(a, d):
        return a.reshape(B, L, -1, d).transpose(0, 2, 1, 3).astype(f32)

    q = heads(ml_q, ML_QK_DIM)
    k = heads(ml_k, ML_QK_DIM) * (ML_QK_DIM ** -0.5)
    v = heads(ml_v, ML_V_DIM)
    ig = (ml_i + b_i).astype(f32).transpose(0, 2, 1)
    lf = jax.nn.log_sigmoid((ml_f + b_f).astype(f32)).transpose(0, 2, 1)
    block = CHUNK if k_cache is None else L
    h, (C, n, m) = mlstm_scan(q, k, v, ig, lf, C.astype(f32), n.astype(f32), m.astype(f32), block)
    h = h.transpose(0, 2, 1, 3).reshape(B, L, ML_WIDTH)
    ml_out = rmsnorm(jax.nn.sigmoid(ml_o.astype(f32)) * h, ml_g)
    dq = da_q.reshape(B, L, DA_HEADS, 2 * DA_HEAD_DIM)
    dk = da_k.reshape(B, L, DA_HEADS, 2 * DA_HEAD_DIM)
    dv = da_v.reshape(B, L, DA_HEADS, DA_V_DIM)
    lam = (jnp.exp(jnp.sum(lq1.astype(f32) * lk1.astype(f32)))
           - jnp.exp(jnp.sum(lq2.astype(f32) * lk2.astype(f32))) + lam_init)
    if k_cache is None:
        att = diff_attn_prompt(dq.astype(f32), dk.astype(f32), dv.astype(f32), lam)
    else:
        P = k_cache.shape[1]
        k_all = jnp.concatenate([k_cache.astype(f32), dk.astype(f32)], axis=1)
        v_all = jnp.concatenate([v_cache.astype(f32), dv.astype(f32)], axis=1)
        att = diff_attn_block(dq.astype(f32), k_all, v_all, P + jnp.arange(L), jnp.arange(P + L), lam)
    da_out = (rmsnorm(att, da_g) * (1.0 - lam_init)).reshape(B, L, DA_WIDTH)
    y = jnp.concatenate([ml_out, da_out], axis=-1).astype(dt) @ w_out
    return y, (dk, dv, C.astype(dt), n.astype(dt), m.astype(dt), conv_new)


def layer(x, lp, lam_init, conv_buf, C, n, m, k_cache, v_cache):
    (f1_pre, f1_wg, f1_wu, f1_wd, f1_post, mx_pre, w_in, b_i, b_f, conv_w, conv_b, ml_g,
     lq1, lk1, lq2, lk2, da_g, w_out, mx_post, f2_pre, f2_wg, f2_wu, f2_wd, f2_post) = lp
    x = x + 0.5 * rmsnorm(swiglu(rmsnorm(x, f1_pre), f1_wg, f1_wu, f1_wd), f1_post)
    y, st = mixer(rmsnorm(x, mx_pre), w_in, b_i, b_f, conv_w, conv_b, ml_g, lq1, lk1, lq2, lk2,
                  da_g, w_out, lam_init, conv_buf, C, n, m, k_cache, v_cache)
    x = x + rmsnorm(y, mx_post)
    x = x + 0.5 * rmsnorm(swiglu(rmsnorm(x, f2_pre), f2_wg, f2_wu, f2_wd), f2_post)
    return x, st


def setup_inputs(seed: int = 0) -> dict:
    key = jax.random.key(seed)
    ks = iter(jax.random.split(key, 40))

    def nrm(shape, scale):
        return jax.random.normal(next(ks), shape, jnp.float32) * scale

    def gain(shape):
        return 1.0 + nrm(shape, 0.01)

    dsc = D_MODEL ** -0.5
    fsc = D_FF ** -0.5
    return {
        "x_prompt": nrm((BATCH, SEQ, D_MODEL), 1.0),
        "x_sample": nrm((DEC_BATCH, DEC_SEQ, D_MODEL), 1.0),
        "cache_k": nrm((DEPTH, DEC_BATCH, PAST_LEN, DA_HEADS, 2 * DA_HEAD_DIM), 1.0),
        "cache_v": nrm((DEPTH, DEC_BATCH, PAST_LEN, DA_HEADS, DA_V_DIM), 1.0),
        "state_C": nrm((DEPTH, DEC_BATCH, ML_HEADS, ML_V_DIM, ML_QK_DIM), 0.1),
        "state_n": nrm((DEPTH, DEC_BATCH, ML_HEADS, ML_QK_DIM), 0.1),
        "state_m": nrm((DEPTH, DEC_BATCH, ML_HEADS), 1.0),
        "state_conv": nrm((DEPTH, DEC_BATCH, CONV_W - 1, ML_CONV_CH), 1.0),
        "ffn1_pre_g": gain((DEPTH, D_MODEL)),
        "ffn1_wg": nrm((DEPTH, D_MODEL, D_FF), dsc),
        "ffn1_wu": nrm((DEPTH, D_MODEL, D_FF), dsc),
        "ffn1_wd": nrm((DEPTH, D_FF, D_MODEL), fsc),
        "ffn1_post_g": gain((DEPTH, D_MODEL)),
        "mix_pre_g": gain((DEPTH, D_MODEL)),
        "w_in": nrm((DEPTH, D_MODEL, N_IN), dsc),
        "b_i": nrm((DEPTH, ML_HEADS), 0.1),
        "b_f": jnp.linspace(3.0, 6.0, ML_HEADS)[None, :] + nrm((DEPTH, ML_HEADS), 0.1),
        "conv_w": nrm((DEPTH, CONV_W, ML_CONV_CH), CONV_W ** -0.5),
        "conv_b": nrm((DEPTH, ML_CONV_CH), 0.01),
        "ml_norm_g": gain((DEPTH, ML_WIDTH)),
        "lam_q1": nrm((DEPTH, DA_HEAD_DIM), 0.1),
        "lam_k1": nrm((DEPTH, DA_HEAD_DIM), 0.1),
        "lam_q2": nrm((DEPTH, DA_HEAD_DIM), 0.1),
        "lam_k2": nrm((DEPTH, DA_HEAD_DIM), 0.1),
        "da_norm_g": gain((DEPTH, DA_V_DIM)),
        "w_out": nrm((DEPTH, MIX_WIDTH, D_MODEL), MIX_WIDTH ** -0.5),
        "mix_post_g": gain((DEPTH, D_MODEL)),
        "ffn2_pre_g": gain((DEPTH, D_MODEL)),
        "ffn2_wg": nrm((DEPTH, D_MODEL, D_FF), dsc),
        "ffn2_wu": nrm((DEPTH, D_MODEL, D_FF), dsc),
        "ffn2_wd": nrm((DEPTH, D_FF, D_MODEL), fsc),
        "ffn2_post_g": gain((DEPTH, D_MODEL)),
    }


def reference(x_prompt, x_sample, cache_k, cache_v, state_C, state_n, state_m, state_conv,
              ffn1_pre_g, ffn1_wg, ffn1_wu, ffn1_wd, ffn1_post_g,
              mix_pre_g, w_in, b_i, b_f, conv_w, conv_b, ml_norm_g,
              lam_q1, lam_k1, lam_q2, lam_k2, da_norm_g, w_out, mix_post_g,
              ffn2_pre_g, ffn2_wg, ffn2_wu, ffn2_wd, ffn2_post_g):
    f32 = jnp.float32
    xp, xs = x_prompt, x_sample
    Bp = xp.shape[0]
    zero_conv = jnp.zeros((Bp, CONV_W - 1, ML_CONV_CH), xp.dtype)
    zero_C = jnp.zeros((Bp, ML_HEADS, ML_V_DIM, ML_QK_DIM), f32)
    zero_n = jnp.zeros((Bp, ML_HEADS, ML_QK_DIM), f32)
    zero_m = jnp.zeros((Bp, ML_HEADS), f32)
    weights = (ffn1_pre_g, ffn1_wg, ffn1_wu, ffn1_wd, ffn1_post_g,
               mix_pre_g, w_in, b_i, b_f, conv_w, conv_b, ml_norm_g,
               lam_q1, lam_k1, lam_q2, lam_k2, da_norm_g, w_out, mix_post_g,
               ffn2_pre_g, ffn2_wg, ffn2_wu, ffn2_wd, ffn2_post_g)
    p_states, s_states = [], []
    for li in range(DEPTH):
        lam_init = 0.8 - 0.6 * math.exp(-0.3 * li)
        lp = tuple(w[li] for w in weights)
        xp, st_p = layer(xp, lp, lam_init, zero_conv, zero_C, zero_n, zero_m, None, None)
        xs, st_s = layer(xs, lp, lam_init, state_conv[li], state_C[li], state_n[li], state_m[li],
                         cache_k[li], cache_v[li])
        p_states.append(st_p)
        s_states.append(st_s)
    p_k, p_v, p_C, p_n, p_m, p_conv = (jnp.stack(e) for e in zip(*p_states))
    s_k, s_v, s_C, s_n, s_m, s_conv = (jnp.stack(e) for e in zip(*s_states))
    return (xp, xs, p_k, p_v, p_C, p_n, p_m, p_conv, s_k, s_v, s_C, s_n, s_m, s_conv)
```

```cpp
#include <hip/hip_runtime.h>
#include <cstdio>
#include <cstdint>
constexpr int DM = 2048, BATCH = 2, SEQ = 4096, DEPTH = 2, DEC_BATCH = 32, DEC_SEQ = 64, PAST = 2048;
constexpr int CHUNK = 64, MLH = 4, MLQK = 128, MLV = 256, DAH = 4, DAD = 128, DAV = 256, CONVW = 4, DFF = 5504;
constexpr int NIN = 6152;
constexpr int MP = BATCH * SEQ;
constexpr int MS = DEC_BATCH * DEC_SEQ;
constexpr int MT = MP + MS;
constexpr float EPS = 1e-6f;
constexpr size_t O_YP = 0, O_YS = 16777216, O_PK = 20971520, O_PV = 37748736, O_PC = 54525952, O_PN = 55050240, O_PM = 55052288, O_PCONV = 55052304,
                 O_SK = 55064592, O_SV = 59258896, O_SC = 63453200, O_SN = 71841808, O_SM = 71874576, O_SCONV = 71874832, O_END = 72071440;
enum { I_XP = 0, I_XS, I_CK, I_CV, I_SC, I_SN, I_SM, I_SCONV, I_F1PRE, I_F1WG, I_F1WU, I_F1WD, I_F1POST, I_MXPRE, I_WIN, I_BI, I_BF, I_CONVW, I_CONVB, I_MLG,
       I_LQ1, I_LK1, I_LQ2, I_LK2, I_DAG, I_WOUT, I_MXPOST, I_F2PRE, I_F2WG, I_F2WU, I_F2WD, I_F2POST, N_INPUTS };
struct Inputs { const float* p[N_INPUTS]; };
__host__ __device__ inline float lam_init_of(int li) { return li == 0 ? 0.2f : 0.35550906759096926f; }
namespace nv {
__device__ inline float wsum(float v) { for (int o = 32; o >= 1; o >>= 1) v += __shfl_xor(v, o); return v; }
__device__ inline float wmax(float v) { for (int o = 32; o >= 1; o >>= 1) v = fmaxf(v, __shfl_xor(v, o)); return v; }
__device__ inline float sigm(float x) { return 1.f / (1.f + expf(-x)); }
__device__ inline float logsig(float x) { return fminf(x, 0.f) - log1pf(expf(-fabsf(x))); }

__global__ void k_rmsnorm(const float* x, int ldx, const float* g, float* out, int ldo, int rows, int n) {
    const int w = (blockIdx.x * blockDim.x + threadIdx.x) >> 6, lane = threadIdx.x & 63, nw = (gridDim.x * blockDim.x) >> 6;
    for (int r = w; r < rows; r += nw) {
        const float* xr = x + (size_t)r * ldx; float s = 0.f;
        for (int c = lane; c < n; c += 64) s += xr[c] * xr[c];
        s = wsum(s); const float rs = rsqrtf(s / n + EPS);
        for (int c = lane; c < n; c += 64) out[(size_t)r * ldo + c] = xr[c] * rs * g[c];
    }
}
__global__ void k_post(float* x, const float* y, const float* g, float scale, int rows, int n) {
    const int w = (blockIdx.x * blockDim.x + threadIdx.x) >> 6, lane = threadIdx.x & 63, nw = (gridDim.x * blockDim.x) >> 6;
    for (int r = w; r < rows; r += nw) {
        const float* yr = y + (size_t)r * n; float s = 0.f;
        for (int c = lane; c < n; c += 64) s += yr[c] * yr[c];
        s = wsum(s); const float rs = rsqrtf(s / n + EPS);
        for (int c = lane; c < n; c += 64) x[(size_t)r * n + c] += scale * yr[c] * rs * g[c];
    }
}
__global__ void __launch_bounds__(256) k_gemm(const float* A, int lda, const float* B, int ldb, float* C, int ldc, int M, int N, int K) {
    __shared__ float As[16][64 + 4], Bs[16][64 + 4];
    const int tid = threadIdx.x, tx = tid & 15, ty = tid >> 4, m0 = blockIdx.y * 64, n0 = blockIdx.x * 64;
    float acc[4][4] = {};
    for (int k0 = 0; k0 < K; k0 += 16) {
        for (int i = tid; i < 64 * 16; i += 256) { const int r = i >> 4, c = i & 15; As[c][r] = A[(size_t)(m0 + r) * lda + k0 + c]; }
        for (int i = tid; i < 16 * 64; i += 256) { const int r = i >> 6, c = i & 63; Bs[r][c] = (n0 + c < N) ? B[(size_t)(k0 + r) * ldb + n0 + c] : 0.f; }
        __syncthreads();
#pragma unroll
        for (int k = 0; k < 16; ++k) {
            float a[4], b[4];
#pragma unroll
            for (int i = 0; i < 4; ++i) { a[i] = As[k][ty * 4 + i]; b[i] = Bs[k][tx * 4 + i]; }
#pragma unroll
            for (int i = 0; i < 4; ++i)
#pragma unroll
                for (int j = 0; j < 4; ++j) acc[i][j] += a[i] * b[j];
        }
        __syncthreads();
    }
    for (int i = 0; i < 4; ++i) for (int j = 0; j < 4; ++j) { const int c = n0 + tx * 4 + j; if (c < N) C[(size_t)(m0 + ty * 4 + i) * ldc + c] = acc[i][j]; }
}
__global__ void k_swiglu(float* g, const float* u, size_t n) { for (size_t i = (size_t)blockIdx.x * blockDim.x + threadIdx.x; i < n; i += (size_t)gridDim.x * blockDim.x) { const float a = g[i]; g[i] = a * sigm(a) * u[i]; } }
__global__ void k_copy(float* d, const float* s, size_t n) { for (size_t i = (size_t)blockIdx.x * blockDim.x + threadIdx.x; i < n; i += (size_t)gridDim.x * blockDim.x) d[i] = s[i]; }

__global__ void k_conv(const float* proj, const float* conv_w, const float* conv_b, const float* state_conv_l, float* qc, float* out, int li) {
    const size_t n = (size_t)MT * 1024;
    for (size_t i = (size_t)blockIdx.x * blockDim.x + threadIdx.x; i < n; i += (size_t)gridDim.x * blockDim.x) {
        const int r = (int)(i >> 10), c = (int)(i & 1023);
        const bool pr = r < MP; const int b = pr ? r / SEQ : (r - MP) / DEC_SEQ, t = pr ? r % SEQ : (r - MP) % DEC_SEQ, L = pr ? SEQ : DEC_SEQ;
        float y = conv_b[c];
        for (int j = 0; j < 4; ++j) { const int tt = t - 3 + j; float xv;
            if (tt >= 0) xv = proj[(size_t)(r - 3 + j) * NIN + c]; else xv = pr ? 0.f : state_conv_l[((size_t)b * 3 + (3 + tt)) * 1024 + c];
            y += xv * conv_w[j * 1024 + c]; }
        float s = y * sigm(y); if (c >= 512) s *= 0.08838834764831845f;
        qc[i] = s;
        if (t >= L - 3) { const int j = t - (L - 3); const float xv = proj[(size_t)r * NIN + c];
            if (pr) out[O_PCONV + (((size_t)li * BATCH + b) * 3 + j) * 1024 + c] = xv; else out[O_SCONV + (((size_t)li * DEC_BATCH + b) * 3 + j) * 1024 + c] = xv; }
    }
}
__global__ void k_kvout(const float* proj, float* out, int li) {
    const size_t n = (size_t)MT * 1024;
    for (size_t i = (size_t)blockIdx.x * blockDim.x + threadIdx.x; i < n; i += (size_t)gridDim.x * blockDim.x) {
        const int r = (int)(i >> 10), c = (int)(i & 1023); const float kv = proj[(size_t)r * NIN + 4104 + c], vv = proj[(size_t)r * NIN + 5128 + c];
        if (r < MP) { out[O_PK + ((size_t)li * MP + r) * 1024 + c] = kv; out[O_PV + ((size_t)li * MP + r) * 1024 + c] = vv; }
        else { out[O_SK + ((size_t)li * MS + (r - MP)) * 1024 + c] = kv; out[O_SV + ((size_t)li * MS + (r - MP)) * 1024 + c] = vv; }
    }
}
__global__ void __launch_bounds__(256) k_mlstm(const float* proj, const float* qc, const float* b_i, const float* b_f, const float* sC, const float* sN, const float* sM,
                                               float* hout  , float* out, int li) {
    __shared__ float qs[128], ks[128], red[4], ns[128];
    const int bid = blockIdx.x, v = threadIdx.x; const bool pr = bid < 8; const int b = pr ? bid / 4 : (bid - 8) / 4, h = bid % 4, L = pr ? SEQ : DEC_SEQ;
    const int row0 = pr ? b * SEQ : MP + b * DEC_SEQ;
    float C[128]; float m;
    const float* c0 = sC + (((size_t)b * 4 + h) * 256 + v) * 128;
#pragma unroll
    for (int d = 0; d < 128; ++d) C[d] = pr ? 0.f : c0[d];
    if (pr) { if (v < 128) ns[v] = 0.f; m = 0.f; }
    else { if (v < 128) ns[v] = sN[((size_t)b * 4 + h) * 128 + v]; m = sM[b * 4 + h]; }
    __syncthreads();
    for (int t = 0; t < L; ++t) {
        const int r = row0 + t;
        if (v < 128) { qs[v] = qc[(size_t)r * 1024 + h * 128 + v]; ks[v] = qc[(size_t)r * 1024 + 512 + h * 128 + v]; }
        const float ig = proj[(size_t)r * NIN + 3072 + h] + b_i[h], lf = logsig(proj[(size_t)r * NIN + 3076 + h] + b_f[h]);
        const float mn = fmaxf(lf + m, ig), fd = expf(lf + m - mn), iw = expf(ig - mn); m = mn;
        const float vv = proj[(size_t)r * NIN + 1024 + h * 256 + v];
        __syncthreads();
        float num = 0.f; const float iv = iw * vv;
#pragma unroll
        for (int d = 0; d < 128; ++d) { C[d] = fd * C[d] + iv * ks[d]; num += C[d] * qs[d]; }
        float dn = 0.f;
        if (v < 128) { const float nn = fd * ns[v] + iw * ks[v]; ns[v] = nn; dn = nn * qs[v]; }
        dn = wsum(dn); if ((v & 63) == 0) red[v >> 6] = dn;
        __syncthreads();
        const float den = red[0] + red[1];
        hout[(size_t)r * 1024 + h * 256 + v] = num / fmaxf(fabsf(den), expf(-m));
        __syncthreads();
    }
    const size_t sidx = pr ? ((size_t)li * BATCH + b) * 4 + h : ((size_t)li * DEC_BATCH + b) * 4 + h;
    float* oc = out + (pr ? O_PC : O_SC) + (sidx * 256 + v) * 128;
#pragma unroll
    for (int d = 0; d < 128; ++d) oc[d] = C[d];
    if (v < 128) out[(pr ? O_PN : O_SN) + sidx * 128 + v] = ns[v];
    if (v == 0) out[(pr ? O_PM : O_SM) + sidx] = m;
}
__global__ void __launch_bounds__(256) k_attn(const float* proj, const float* cache_k_l, const float* cache_v_l, const float* lam_p, float* att) {
    const float lam = *lam_p;
    __shared__ float q[256], sc1[4160], sc2[4160], red[8];
    const int r = blockIdx.x, h = blockIdx.y, tid = threadIdx.x; const bool pr = r < MP;
    const int b = pr ? r / SEQ : (r - MP) / DEC_SEQ, t = pr ? r % SEQ : (r - MP) % DEC_SEQ;
    const int nk = pr ? (t / 64 + 1) * 64 : PAST + 64;
    q[tid] = proj[(size_t)r * NIN + 3080 + h * 256 + tid];
    __syncthreads();
    float mx1 = -3e38f, mx2 = -3e38f;
    for (int k = tid; k < nk; k += 256) {
        const float* kr; if (pr) kr = proj + (size_t)(b * SEQ + k) * NIN + 4104 + h * 256; else if (k < PAST) kr = cache_k_l + (((size_t)b * PAST + k) * 4 + h) * 256; else kr = proj + (size_t)(MP + b * 64 + (k - PAST)) * NIN + 4104 + h * 256;
        float s1 = 0.f, s2 = 0.f; for (int d = 0; d < 128; ++d) { s1 += q[d] * kr[d]; s2 += q[128 + d] * kr[128 + d]; }
        s1 *= 0.08838834764831845f; s2 *= 0.08838834764831845f; sc1[k] = s1; sc2[k] = s2; mx1 = fmaxf(mx1, s1); mx2 = fmaxf(mx2, s2);
    }
    mx1 = wmax(mx1); mx2 = wmax(mx2); if ((tid & 63) == 0) { red[tid >> 6] = mx1; red[4 + (tid >> 6)] = mx2; }
    __syncthreads();
    mx1 = fmaxf(fmaxf(red[0], red[1]), fmaxf(red[2], red[3])); mx2 = fmaxf(fmaxf(red[4], red[5]), fmaxf(red[6], red[7]));
    __syncthreads();
    float l1 = 0.f, l2 = 0.f;
    for (int k = tid; k < nk; k += 256) { const float e1 = expf(sc1[k] - mx1), e2 = expf(sc2[k] - mx2); sc1[k] = e1; sc2[k] = e2; l1 += e1; l2 += e2; }
    l1 = wsum(l1); l2 = wsum(l2); if ((tid & 63) == 0) { red[tid >> 6] = l1; red[4 + (tid >> 6)] = l2; }
    __syncthreads();
    l1 = red[0] + red[1] + red[2] + red[3]; l2 = red[4] + red[5] + red[6] + red[7];
    const float i1 = 1.f / l1, i2 = lam / l2; float o = 0.f;
    for (int k = 0; k < nk; ++k) {
        float vv; if (pr) vv = proj[(size_t)(b * SEQ + k) * NIN + 5128 + h * 256 + tid]; else if (k < PAST) vv = cache_v_l[(((size_t)b * PAST + k) * 4 + h) * 256 + tid]; else vv = proj[(size_t)(MP + b * 64 + (k - PAST)) * NIN + 5128 + h * 256 + tid];
        o += (sc1[k] * i1 - sc2[k] * i2) * vv;
    }
    att[(size_t)r * 1024 + h * 256 + tid] = o;
}
__global__ void __launch_bounds__(256) k_merge(const float* proj, const float* hout, const float* att, const float* ml_g, const float* da_g, float one_m_lam, float* mix) {
    __shared__ float red[4];
    const int r = blockIdx.x, tid = threadIdx.x; float g[4]; float s = 0.f;
    for (int j = 0; j < 4; ++j) { const int c = tid + 256 * j; g[j] = sigm(proj[(size_t)r * NIN + 2048 + c]) * hout[(size_t)r * 1024 + c]; s += g[j] * g[j]; }
    s = wsum(s); if ((tid & 63) == 0) red[tid >> 6] = s; __syncthreads();
    const float rs = rsqrtf((red[0] + red[1] + red[2] + red[3]) / 1024.f + EPS);
    for (int j = 0; j < 4; ++j) { const int c = tid + 256 * j; mix[(size_t)r * 2048 + c] = g[j] * rs * ml_g[c]; }
    for (int h = 0; h < 4; ++h) { __syncthreads(); const float a = att[(size_t)r * 1024 + h * 256 + tid]; float q = wsum(a * a); if ((tid & 63) == 0) red[tid >> 6] = q; __syncthreads();
        const float r2 = rsqrtf((red[0] + red[1] + red[2] + red[3]) / 256.f + EPS); mix[(size_t)r * 2048 + 1024 + h * 256 + tid] = a * r2 * da_g[tid] * one_m_lam; }
}
__global__ void k_lam(const float* q1, const float* k1, const float* q2, const float* k2, float* lam  ) {
    const int li = blockIdx.x, lane = threadIdx.x; float a = 0.f, b = 0.f;
    for (int i = lane; i < 128; i += 64) { a += q1[li * 128 + i] * k1[li * 128 + i]; b += q2[li * 128 + i] * k2[li * 128 + i]; }
    a = wsum(a); b = wsum(b); if (lane == 0) lam[li] = expf(a) - expf(b) + lam_init_of(li);
}

constexpr size_t NB_X = 0, NB_HN = NB_X + (size_t)MT * DM * 4, NB_G = NB_HN + (size_t)MT * DM * 4, NB_U = NB_G + (size_t)MT * NIN * 4, NB_Y = NB_U + (size_t)MT * DFF * 4,
                 NB_QC = NB_Y + (size_t)MT * DM * 4, NB_H = NB_QC + (size_t)MT * 1024 * 4, NB_ATT = NB_H + (size_t)MT * 1024 * 4, NB_LAM = NB_ATT + (size_t)MT * 1024 * 4, NB_END = NB_LAM + 256;
struct Bufs { float *x, *hn, *g, *u, *y, *qc, *h, *att, *lam; };
inline Bufs bufs(char* base) { Bufs b; b.x = (float*)(base + NB_X); b.hn = (float*)(base + NB_HN); b.g = (float*)(base + NB_G); b.u = (float*)(base + NB_U); b.y = (float*)(base + NB_Y);
    b.qc = (float*)(base + NB_QC); b.h = (float*)(base + NB_H); b.att = (float*)(base + NB_ATT); b.lam = (float*)(base + NB_LAM); return b; }

inline void gemm(const float* A, int lda, const float* B, int ldb, float* C, int ldc, int M, int N, int K, hipStream_t s) {
    k_gemm<<<dim3((N + 63) / 64, M / 64), 256, 0, s>>>(A, lda, B, ldb, C, ldc, M, N, K); }
inline void ffn(const Bufs& b, const float* pre, const float* wg, const float* wu, const float* wd, const float* post, hipStream_t s) {
    k_rmsnorm<<<1024, 256, 0, s>>>(b.x, DM, pre, b.hn, DM, MT, DM);
    gemm(b.hn, DM, wg, DFF, b.g, DFF, MT, DFF, DM, s); gemm(b.hn, DM, wu, DFF, b.u, DFF, MT, DFF, DM, s);
    k_swiglu<<<2048, 256, 0, s>>>(b.g, b.u, (size_t)MT * DFF);
    gemm(b.g, DFF, wd, DM, b.y, DM, MT, DM, DFF, s);
    k_post<<<1024, 256, 0, s>>>(b.x, b.y, post, 0.5f, MT, DM);
}
inline void forward(const Inputs& in, float* out, char* base, hipStream_t s) {
    const Bufs b = bufs(base);
    k_copy<<<2048, 256, 0, s>>>(b.x, in.p[I_XP], (size_t)MP * DM); k_copy<<<1024, 256, 0, s>>>(b.x + (size_t)MP * DM, in.p[I_XS], (size_t)MS * DM);
    k_lam<<<DEPTH, 64, 0, s>>>(in.p[I_LQ1], in.p[I_LK1], in.p[I_LQ2], in.p[I_LK2], b.lam);
    for (int li = 0; li < DEPTH; ++li) {
        const float lam_init = lam_init_of(li);
        ffn(b, in.p[I_F1PRE] + li * DM, in.p[I_F1WG] + (size_t)li * DM * DFF, in.p[I_F1WU] + (size_t)li * DM * DFF, in.p[I_F1WD] + (size_t)li * DFF * DM, in.p[I_F1POST] + li * DM, s);
        k_rmsnorm<<<1024, 256, 0, s>>>(b.x, DM, in.p[I_MXPRE] + li * DM, b.hn, DM, MT, DM);
        float* proj = b.g;
        gemm(b.hn, DM, in.p[I_WIN] + (size_t)li * DM * NIN, NIN, proj, NIN, MT, NIN, DM, s);
        k_conv<<<2048, 256, 0, s>>>(proj, in.p[I_CONVW] + li * 4 * 1024, in.p[I_CONVB] + li * 1024, in.p[I_SCONV] + (size_t)li * DEC_BATCH * 3 * 1024, b.qc, out, li);
        k_kvout<<<2048, 256, 0, s>>>(proj, out, li);
        k_mlstm<<<8 + 128, 256, 0, s>>>(proj, b.qc, in.p[I_BI] + li * 4, in.p[I_BF] + li * 4, in.p[I_SC] + (size_t)li * DEC_BATCH * 4 * 256 * 128, in.p[I_SN] + (size_t)li * DEC_BATCH * 4 * 128,
                                       in.p[I_SM] + li * DEC_BATCH * 4, b.h, out, li);
        hipLaunchKernelGGL(k_attn, dim3(MT, 4), dim3(256), 0, s, proj, in.p[I_CK] + (size_t)li * DEC_BATCH * PAST * 1024, in.p[I_CV] + (size_t)li * DEC_BATCH * PAST * 1024, b.lam + li, b.att);
        k_merge<<<MT, 256, 0, s>>>(proj, b.h, b.att, in.p[I_MLG] + li * 1024, in.p[I_DAG] + li * 256, 1.f - lam_init, b.u  );
        gemm(b.u, DM, in.p[I_WOUT] + (size_t)li * DM * DM, DM, b.y, DM, MT, DM, DM, s);
        k_post<<<1024, 256, 0, s>>>(b.x, b.y, in.p[I_MXPOST] + li * DM, 1.0f, MT, DM);
        ffn(b, in.p[I_F2PRE] + li * DM, in.p[I_F2WG] + (size_t)li * DM * DFF, in.p[I_F2WU] + (size_t)li * DM * DFF, in.p[I_F2WD] + (size_t)li * DFF * DM, in.p[I_F2POST] + li * DM, s);
    }
    k_copy<<<2048, 256, 0, s>>>(out + O_YP, b.x, (size_t)MP * DM); k_copy<<<1024, 256, 0, s>>>(out + O_YS, b.x + (size_t)MP * DM, (size_t)MS * DM);
}
}
extern "C" void kernel_launch(void* const* d_in, const int* in_sizes, int n_in, void* d_out, int out_size, void* d_ws, size_t ws_size, hipStream_t stream) {
    Inputs in; for (int i = 0; i < N_INPUTS; ++i) in.p[i] = (const float*)d_in[i];
    nv::forward(in, (float*)d_out, (char*)d_ws, stream);
}
```

```cpp
#define MK_FUSED 0
#include <hip/hip_runtime.h>
#include <cstdio>
#include <cstdint>
constexpr int DM = 2048, BATCH = 2, SEQ = 4096, DEPTH = 2, DEC_BATCH = 32, DEC_SEQ = 64, PAST = 2048;
constexpr int CHUNK = 64, MLH = 4, MLQK = 128, MLV = 256, DAH = 4, DAD = 128, DAV = 256, CONVW = 4, DFF = 5504;
constexpr int NIN = 6152;
constexpr int MP = BATCH * SEQ;
constexpr int MS = DEC_BATCH * DEC_SEQ;
constexpr int MT = MP + MS;
constexpr float EPS = 1e-6f;
constexpr size_t O_YP = 0, O_YS = 16777216, O_PK = 20971520, O_PV = 37748736, O_PC = 54525952, O_PN = 55050240, O_PM = 55052288, O_PCONV = 55052304,
                 O_SK = 55064592, O_SV = 59258896, O_SC = 63453200, O_SN = 71841808, O_SM = 71874576, O_SCONV = 71874832, O_END = 72071440;
enum { I_XP = 0, I_XS, I_CK, I_CV, I_SC, I_SN, I_SM, I_SCONV, I_F1PRE, I_F1WG, I_F1WU, I_F1WD, I_F1POST, I_MXPRE, I_WIN, I_BI, I_BF, I_CONVW, I_CONVB, I_MLG,
       I_LQ1, I_LK1, I_LQ2, I_LK2, I_DAG, I_WOUT, I_MXPOST, I_F2PRE, I_F2WG, I_F2WU, I_F2WD, I_F2POST, N_INPUTS };
struct Inputs { const float* p[N_INPUTS]; };
__host__ __device__ inline float lam_init_of(int li) { return li == 0 ? 0.2f : 0.35550906759096926f; }
namespace op {
constexpr size_t MiB = 1u << 20;
constexpr size_t WS_CTL = 0, CTL_ZERO_BYTES = 1 * MiB;
constexpr int CW_BAR = 4096;
constexpr size_t SZ_WA = (size_t)2 * DFF * DM * 2, SZ_WD = (size_t)DM * DFF * 2, SZ_WIN = (size_t)6144 * DM * 2, SZ_WOUT = (size_t)DM * DM * 2, SZ_WG = (size_t)8 * DM * 4;
constexpr size_t LW_W1A = 0, LW_W1D = LW_W1A + SZ_WA, LW_WIN = LW_W1D + SZ_WD, LW_WOUT = LW_WIN + SZ_WIN, LW_W2A = LW_WOUT + SZ_WOUT, LW_W2D = LW_W2A + SZ_WA, LW_WG = LW_W2D + SZ_WD, LW_SIZE = LW_WG + SZ_WG;
constexpr size_t WS_W = 1 * MiB;
constexpr size_t WS_HN = WS_W + DEPTH * LW_SIZE;
constexpr size_t WS_ACT = WS_HN + (size_t)MT * DM * 2;
constexpr size_t WS_Y = WS_ACT + (size_t)MT * DFF * 2;
constexpr size_t WS_QKRAW = WS_Y + (size_t)MT * DM * 4;
constexpr size_t SZ_B1K = (size_t)MT * 1024 * 2;
constexpr size_t WS_MLV = WS_QKRAW + (size_t)MT * 1024 * 4, WS_MLO = WS_MLV + SZ_B1K, WS_DAQ = WS_MLO + SZ_B1K, WS_DAK = WS_DAQ + SZ_B1K, WS_DAV = WS_DAK + SZ_B1K, WS_QC = WS_DAV + SZ_B1K;
constexpr size_t WS_GATES = WS_QC + SZ_B1K;
constexpr size_t WS_END1 = WS_GATES + (size_t)MT * 8 * 4;
static_assert(LW_SIZE % 256 == 0 && WS_HN % 256 == 0 && WS_ACT % 256 == 0 && WS_Y % 256 == 0 && WS_GATES % 256 == 0, "ws alignment");

constexpr int NCK = 160;
constexpr int CHK_STRIDE = 256;
constexpr size_t WS_CHK = WS_END1;
constexpr size_t WS_SC = WS_CHK + (size_t)NCK * 4 * CHK_STRIDE * 4;
constexpr size_t WS_DN = WS_SC + (size_t)512 * 4 * 4;
constexpr size_t WS_DC = WS_DN + (size_t)512 * 128 * 4;
constexpr size_t WS_HML = WS_DC + (size_t)512 * 256 * 128 * 4;
constexpr size_t WS_END2 = WS_HML + (size_t)MT * 1024 * 4;
static_assert(WS_DC % 256 == 0 && WS_HML % 256 == 0, "ws alignment 2");

}
namespace pg8 {
#define PG8_LAS __attribute__((address_space(3)))
typedef unsigned short bf16_t;
typedef short bf16x8 __attribute__((ext_vector_type(8)));
typedef float f32x4 __attribute__((ext_vector_type(4)));
typedef unsigned u32x4 __attribute__((ext_vector_type(4)));
constexpr int BM = 256, BK = 64, HALF = 128, HTB = HALF * BK * 2  , STAGE_BYTES = 8 * HTB, NXCD = 8, WGM = 8;

__host__ __device__ __forceinline__ int lds_byte(int r, int c) { const int st = (r >> 4) * 2 + (c >> 5), rr = r & 15, cc = c & 31, ob = rr * 64 + cc * 2; return st * 1024 + (ob ^ (((ob >> 9) & 1) << 5)); }
__host__ __device__ __forceinline__ void stage_rc(int b, int& R, int& C) { const int st = b / 1024, sb = b % 1024, swz = sb ^ (((sb >> 9) & 1) << 5); R = (st >> 1) * 16 + swz / 64; C = (st & 1) * 32 + (swz % 64) / 2; }
__host__ __device__ __forceinline__ int perm32(int rho) { const int n = rho >> 4, i = rho & 15; return 8 * (i >> 2) + 4 * n + (i & 3); }

struct Unit { int pm, pn; };
struct Gemm { const bf16_t* A; const bf16_t* Bt; int M, N, K; };

struct StaticOrder {
    int nM, nN, nwg, G, c;
    __host__ __device__ void init(int M, int N, int G_, int c_) { nM = M / BM; nN = N / BM; nwg = nM * nN; G = G_; c = c_; }
    __host__ __device__ bool next(int i, Unit& u) const {
        const long L = (long)i * G + c; if (L >= nwg) return false;
        int wgid = (int)L; { const int q = nwg / NXCD, r = nwg % NXCD, xcd = wgid % NXCD, off = wgid / NXCD; wgid = (xcd < r ? xcd * (q + 1) : r * (q + 1) + (xcd - r) * q) + off; }
        const int nig = WGM * nN, gid = wgid / nig, fm = gid * WGM, gsz = (nM - fm) < WGM ? (nM - fm) : WGM;
        u.pm = fm + ((wgid % nig) % gsz); u.pn = (wgid % nig) / gsz; return true;
    }
    __device__ __forceinline__ void a_ready(const Unit&) const {}
    __device__ __forceinline__ void done(const Unit&) const {}
};
__device__ __forceinline__ unsigned cvt_pk_bf16(float lo, float hi) { unsigned r; asm volatile("v_cvt_pk_bf16_f32 %0, %1, %2" : "=v"(r) : "v"(lo), "v"(hi)); return r; }
template <class Epi, class Sched, bool ALIGN_EPI = false, bool SP2 = false, int KC = 0>
__device__ __forceinline__ void gemm_phase(PG8_LAS unsigned char* lds, const Gemm g, const Sched& S, const Epi& E) {
    int tid_o = threadIdx.x; asm volatile("" : "+v"(tid_o));
    const int tid = tid_o, wid = __builtin_amdgcn_readfirstlane(tid >> 6), lane = tid & 63, wr = wid >> 2, wc = wid & 3, fr = lane & 15, fq = lane >> 4;
    const int K = KC ? KC : g.K, nt = K / BK;
    unsigned voffA[2], voffB[2];
#pragma unroll
    for (int i = 0; i < 2; ++i) { int R, C; stage_rc(tid * 16 + i * 8192, R, C); const int Rb = Epi::PERM ? ((R & ~31) + perm32(R & 31)) : R;
        voffA[i] = (unsigned)(R * K + C) * 2u; voffB[i] = (unsigned)(Rb * K + C) * 2u; }
    const size_t kstep = (size_t)(BK * 2);
    const size_t hstep = (size_t)HALF * K * 2;
    const size_t tstep = 2 * hstep;
    const unsigned ldsw = (unsigned)wid * 1024u;
    const int aoff = lds_byte(wr * 64 + fr, fq * 8), boff = lds_byte(wc * 32 + fr, fq * 8);
#define PG8_SA(b, h) (((b) * 2 + (h)) * HTB)
#define PG8_SB(b, h) ((4 + (b) * 2 + (h)) * HTB)
#define PG8_STAGE(bufoff, gbase, voff) do { _Pragma("unroll") for (int _i = 0; _i < 2; ++_i) \
        __builtin_amdgcn_global_load_lds((const unsigned*)((const char*)(gbase) + (voff)[_i]), (PG8_LAS unsigned*)(lds + (bufoff) + ldsw + _i * 8192), 16, 0, 0); } while (0)
#define PG8_LDA(dst, b, h) do { _Pragma("unroll") for (int m = 0; m < 4; ++m) _Pragma("unroll") for (int k = 0; k < 2; ++k) dst[m][k] = *(const PG8_LAS bf16x8*)(lds + PG8_SA(b, h) + aoff + m * 2048 + k * 1024); } while (0)
#define PG8_LDB(dst, b, h) do { _Pragma("unroll") for (int n = 0; n < 2; ++n) _Pragma("unroll") for (int k = 0; k < 2; ++k) dst[n][k] = *(const PG8_LAS bf16x8*)(lds + PG8_SB(b, h) + boff + n * 2048 + k * 1024); } while (0)
#define PG8_MMA(ai, bj, At, Bt) do { __builtin_amdgcn_s_setprio(1); _Pragma("unroll") for (int m = 0; m < 4; ++m) _Pragma("unroll") for (int n = 0; n < 2; ++n) _Pragma("unroll") for (int k = 0; k < 2; ++k) \
        acc[ai][bj][m][n] = __builtin_amdgcn_mfma_f32_16x16x32_bf16(Bt[n][k], At[m][k], acc[ai][bj][m][n], 0, 0, 0); __builtin_amdgcn_s_setprio(0); } while (0)
#define PG8_WAIT_V(n) asm volatile("s_waitcnt vmcnt(" #n ")" ::: "memory")
#define PG8_WAIT_L(n) asm volatile("s_waitcnt lgkmcnt(" #n ")" ::: "memory")
#define PG8_BAR __builtin_amdgcn_s_barrier()
#define PG8_SCHED __builtin_amdgcn_sched_barrier(0)
    Unit cur, nxt; int ui = 0;
    if (!S.next(0, cur)) return;
    f32x4 acc[2][2][4][2];
#pragma unroll
    for (int a = 0; a < 2; ++a)
#pragma unroll
        for (int b = 0; b < 2; ++b)
#pragma unroll
            for (int m = 0; m < 4; ++m)
#pragma unroll
                for (int n = 0; n < 2; ++n) acc[a][b][m][n] = (f32x4){0.f, 0.f, 0.f, 0.f};
    bf16x8 At[4][2], B0[2][2], B1[2][2];
    const char* cA = (const char*)g.A + (size_t)cur.pm * tstep; const char* cB = (const char*)g.Bt + (size_t)cur.pn * tstep;
    S.a_ready(cur);
    if constexpr (SP2) {
        PG8_STAGE(PG8_SB(0, 0), cB, voffB); PG8_STAGE(PG8_SB(0, 1), cB + hstep, voffB); PG8_STAGE(PG8_SA(0, 0), cA, voffA); PG8_STAGE(PG8_SA(0, 1), cA + hstep, voffA);
        if (wr == 1) PG8_BAR;
        PG8_WAIT_V(2); PG8_BAR;
        PG8_STAGE(PG8_SB(1, 0), cB + kstep, voffB); PG8_STAGE(PG8_SA(1, 0), cA + kstep, voffA); PG8_STAGE(PG8_SB(1, 1), cB + hstep + kstep, voffB);
        PG8_WAIT_V(6); PG8_BAR;
    } else {
        PG8_STAGE(PG8_SB(0, 0), cB, voffB); PG8_STAGE(PG8_SA(0, 0), cA, voffA); PG8_STAGE(PG8_SB(0, 1), cB + hstep, voffB); PG8_STAGE(PG8_SA(0, 1), cA + hstep, voffA);
        if (wr == 1) PG8_BAR;
        PG8_WAIT_V(4); PG8_BAR;
        PG8_STAGE(PG8_SB(1, 0), cB + kstep, voffB); PG8_STAGE(PG8_SA(1, 0), cA + kstep, voffA); PG8_STAGE(PG8_SB(1, 1), cB + hstep + kstep, voffB);
        PG8_WAIT_V(6); PG8_BAR;
    }
    for (;;) {
        const bool has_next = S.next(ui + 1, nxt);
        const char* nA = has_next ? (const char*)g.A + (size_t)nxt.pm * tstep : cA; const char* nB = has_next ? (const char*)g.Bt + (size_t)nxt.pn * tstep : cB;
        for (int t = 0; t < nt; t += 2) {
            const bool last = (t == nt - 2);
            const char* a1 = cA + (size_t)(t + 1) * kstep;
            const char* a2 = last ? nA : cA + (size_t)(t + 2) * kstep; const char* b2 = last ? nB : cB + (size_t)(t + 2) * kstep;
            const char* a3 = a2 + kstep; const char* b3 = b2 + kstep;
            if (last && has_next) S.a_ready(nxt);
            if constexpr (SP2) {
            PG8_LDB(B0, 0, 0); PG8_LDB(B1, 0, 1); PG8_SCHED; PG8_LDA(At, 0, 0); PG8_STAGE(PG8_SA(1, 1), a1 + hstep, voffA);
            PG8_WAIT_V(8); PG8_WAIT_L(0); PG8_BAR; PG8_MMA(0, 0, At, B0); PG8_MMA(0, 1, At, B1); PG8_BAR; PG8_SCHED;
            PG8_LDA(At, 0, 1); PG8_STAGE(PG8_SB(0, 0), b2, voffB); PG8_STAGE(PG8_SB(0, 1), b2 + hstep, voffB); PG8_STAGE(PG8_SA(0, 0), a2, voffA);
            PG8_WAIT_V(8); PG8_WAIT_L(0); PG8_BAR; PG8_MMA(1, 0, At, B0); PG8_MMA(1, 1, At, B1); PG8_BAR; PG8_SCHED;
            PG8_LDB(B0, 1, 0); PG8_LDB(B1, 1, 1); PG8_SCHED; PG8_LDA(At, 1, 0); PG8_STAGE(PG8_SA(0, 1), a2 + hstep, voffA);
            PG8_WAIT_V(8); PG8_WAIT_L(0); PG8_BAR; PG8_MMA(0, 0, At, B0); PG8_MMA(0, 1, At, B1); PG8_BAR; PG8_SCHED;
            PG8_LDA(At, 1, 1); PG8_STAGE(PG8_SB(1, 0), b3, voffB); PG8_STAGE(PG8_SB(1, 1), b3 + hstep, voffB); PG8_STAGE(PG8_SA(1, 0), a3, voffA);
            PG8_WAIT_V(8); PG8_WAIT_L(0); PG8_BAR; PG8_MMA(1, 0, At, B0); PG8_MMA(1, 1, At, B1); PG8_BAR; PG8_SCHED;
            } else {
            PG8_LDB(B0, 0, 0); PG8_SCHED; PG8_LDA(At, 0, 0); PG8_STAGE(PG8_SA(1, 1), a1 + hstep, voffA);
            PG8_WAIT_L(8); PG8_BAR; PG8_WAIT_L(0); PG8_MMA(0, 0, At, B0); PG8_BAR; PG8_SCHED;
            PG8_LDB(B1, 0, 1); PG8_STAGE(PG8_SB(0, 0), b2, voffB);
            PG8_BAR; PG8_WAIT_L(0); PG8_MMA(0, 1, At, B1); PG8_BAR;
            PG8_LDA(At, 0, 1); PG8_STAGE(PG8_SA(0, 0), a2, voffA);
            PG8_BAR; PG8_WAIT_L(0); PG8_MMA(1, 0, At, B0); PG8_BAR; PG8_SCHED;
            PG8_STAGE(PG8_SB(0, 1), b2 + hstep, voffB);
            PG8_WAIT_V(6); PG8_BAR; PG8_MMA(1, 1, At, B1); PG8_BAR;
            PG8_LDB(B0, 1, 0); PG8_SCHED; PG8_LDA(At, 1, 0); PG8_STAGE(PG8_SA(0, 1), a2 + hstep, voffA);
            PG8_WAIT_L(8); PG8_BAR; PG8_WAIT_L(0); PG8_MMA(0, 0, At, B0); PG8_BAR; PG8_SCHED;
            PG8_LDB(B1, 1, 1); PG8_STAGE(PG8_SB(1, 0), b3, voffB);
            PG8_BAR; PG8_WAIT_L(0); PG8_MMA(0, 1, At, B1); PG8_BAR;
            PG8_LDA(At, 1, 1); PG8_STAGE(PG8_SA(1, 0), a3, voffA);
            PG8_BAR; PG8_WAIT_L(0); PG8_MMA(1, 0, At, B0); PG8_BAR; PG8_SCHED;
            PG8_STAGE(PG8_SB(1, 1), b3 + hstep, voffB);
            PG8_WAIT_V(6); PG8_BAR; PG8_MMA(1, 1, At, B1); PG8_BAR;
            }
        }
        if constexpr (ALIGN_EPI) { if (wr == 0) PG8_BAR; }
        if constexpr (!Epi::AFTER_DRAIN) { E(acc, cur, wr, wc, fr, fq); S.done(cur); }
        if (!has_next) break;
#pragma unroll
        for (int a = 0; a < 2; ++a)
#pragma unroll
            for (int b = 0; b < 2; ++b)
#pragma unroll
                for (int m = 0; m < 4; ++m)
#pragma unroll
                    for (int n = 0; n < 2; ++n) acc[a][b][m][n] = (f32x4){0.f, 0.f, 0.f, 0.f};
        cur = nxt; cA = nA; cB = nB; ++ui;
        if constexpr (ALIGN_EPI) { if (wr == 1) PG8_BAR; }
    }
    PG8_WAIT_V(0);
    if constexpr (!ALIGN_EPI) { if (wr == 0) PG8_BAR; }
    PG8_BAR;
    if constexpr (Epi::AFTER_DRAIN) { E.fused(acc, cur, wr, wc, fr, fq, lds, wid, lane); S.done(cur); }
#undef PG8_SA
#undef PG8_SB
#undef PG8_STAGE
#undef PG8_LDA
#undef PG8_LDB
#undef PG8_MMA
#undef PG8_WAIT_V
#undef PG8_WAIT_L
#undef PG8_BAR
#undef PG8_SCHED
}
}
namespace pg8 {
typedef float f32x2 __attribute__((ext_vector_type(2)));
__device__ __forceinline__ float fast_sigm(float x) { return __builtin_amdgcn_rcpf(1.0f + __builtin_amdgcn_exp2f(-1.4426950408889634f * x)); }
struct EpiSwiGLU {
    static constexpr bool PERM = true, AFTER_DRAIN = false;
    bf16_t* O; int ldc;
    __device__ __forceinline__ void operator()(const f32x4 (&acc)[2][2][4][2], const Unit& u, int wr, int wc, int fr, int fq) const {
        const int row0 = u.pm * BM + wr * 64 + fr, col0 = u.pn * 128 + wc * 32 + 8 * fq;
#pragma unroll
        for (int ai = 0; ai < 2; ++ai)
#pragma unroll
            for (int m = 0; m < 4; ++m) { bf16_t* rowp = O + (size_t)(row0 + ai * HALF + m * 16) * ldc + col0;
                float v[8];
#pragma unroll
                for (int n = 0; n < 2; ++n)
#pragma unroll
                    for (int j = 0; j < 4; ++j) { const float g = acc[ai][0][m][n][j], up = acc[ai][1][m][n][j]; v[n * 4 + j] = g * fast_sigm(g) * up; }
                u32x4 w; w.x = cvt_pk_bf16(v[0], v[1]); w.y = cvt_pk_bf16(v[2], v[3]); w.z = cvt_pk_bf16(v[4], v[5]); w.w = cvt_pk_bf16(v[6], v[7]);
                *(u32x4*)rowp = w; }
    }
};
struct EpiF32 {
    static constexpr bool PERM = false, AFTER_DRAIN = false;
    float* C; int ldc;
    __device__ __forceinline__ void operator()(const f32x4 (&acc)[2][2][4][2], const Unit& u, int wr, int wc, int fr, int fq) const {
        const int row0 = u.pm * BM + wr * 64 + fr, col0 = u.pn * BM + wc * 32 + 4 * fq;
#pragma unroll
        for (int ai = 0; ai < 2; ++ai)
#pragma unroll
            for (int m = 0; m < 4; ++m) { float* rowp = C + (size_t)(row0 + ai * HALF + m * 16) * ldc + col0;
#pragma unroll
                for (int bj = 0; bj < 2; ++bj)
#pragma unroll
                    for (int n = 0; n < 2; ++n) *(f32x4*)(rowp + bj * HALF + n * 16) = acc[ai][bj][m][n]; }
    }
};
struct EpiWin {
    static constexpr bool PERM = true, AFTER_DRAIN = false;
    unsigned char* ws; float* out; int li;
    __device__ __forceinline__ void operator()(const f32x4 (&acc)[2][2][4][2], const Unit& u, int wr, int wc, int fr, int fq) const {
        const int seg = u.pn >> 2, row0 = u.pm * BM + wr * 64 + fr, col0 = (u.pn & 3) * BM + wc * 32 + 8 * fq;
        bf16_t* ob = (bf16_t*)(ws + (seg == 1 ? op::WS_MLV : seg == 2 ? op::WS_MLO : seg == 3 ? op::WS_DAQ : seg == 4 ? op::WS_DAK : op::WS_DAV));
        float* of = nullptr; int frow = row0;
        if (seg == 0) of = (float*)(ws + op::WS_QKRAW);
        else if (seg >= 4) { if (u.pm < MP / BM) of = out + (seg == 4 ? O_PK : O_PV) + (size_t)li * MP * 1024; else { of = out + (seg == 4 ? O_SK : O_SV) + (size_t)li * MS * 1024; frow = row0 - MP; } }
#pragma unroll
        for (int ai = 0; ai < 2; ++ai)
#pragma unroll
            for (int m = 0; m < 4; ++m) {
                const int r = row0 + ai * HALF + m * 16, rf = frow + ai * HALF + m * 16;
#pragma unroll
                for (int bj = 0; bj < 2; ++bj) { const f32x4 v0 = acc[ai][bj][m][0], v1 = acc[ai][bj][m][1];
                    if (seg != 0) { u32x4 w; w.x = cvt_pk_bf16(v0[0], v0[1]); w.y = cvt_pk_bf16(v0[2], v0[3]); w.z = cvt_pk_bf16(v1[0], v1[1]); w.w = cvt_pk_bf16(v1[2], v1[3]);
                        *(u32x4*)(ob + (size_t)r * 1024 + col0 + bj * HALF) = w; }
                    if (of) { float* p = of + (size_t)rf * 1024 + col0 + bj * HALF; *(f32x4*)p = v0; *(f32x4*)(p + 4) = v1; } } }
    }
};
}

namespace op {
#define GAS __attribute__((address_space(1)))
#define LAS __attribute__((address_space(3)))
typedef unsigned short bf16;
typedef unsigned v4u __attribute__((ext_vector_type(4)));
typedef unsigned v2u __attribute__((ext_vector_type(2)));
typedef float f32x4 __attribute__((ext_vector_type(4)));
typedef short bf16x8 __attribute__((ext_vector_type(8)));
typedef GAS unsigned gu32;
#define RLX_AGENT __ATOMIC_RELAXED, __HIP_MEMORY_SCOPE_AGENT
#define LDS_WAIT() asm volatile("s_waitcnt lgkmcnt(0)" ::: "memory")
#define VM_WAIT() asm volatile("s_waitcnt vmcnt(0)" ::: "memory")
__device__ __forceinline__ unsigned f2bf(float f) { unsigned u = __builtin_bit_cast(unsigned, f); return (u + 0x7fffu + ((u >> 16) & 1u)) >> 16; }
__device__ __forceinline__ unsigned pk2(float lo, float hi) { return f2bf(lo) | (f2bf(hi) << 16); }
__device__ __forceinline__ float bf2f(unsigned short b) { return __builtin_bit_cast(float, ((unsigned)b) << 16); }
__device__ __forceinline__ float wave_sum(float v) {
#pragma unroll
    for (int o = 1; o < 64; o <<= 1) v += __shfl_xor(v, o);
    return v;
}
__device__ __forceinline__ float wave_max(float v) {
#pragma unroll
    for (int o = 1; o < 64; o <<= 1) v = fmaxf(v, __shfl_xor(v, o));
    return v;
}

#define XB_TMO      128
#define XB_XCNT(j)  (256  + 64 * (j))
#define XB_XSUB(j)  (1280 + 64 * (j))
#define XB_XGEN(j)  (2304 + 64 * (j))
#define XB_TOP      3328
#define XB_TOPGEN   3392
#define XCD_BAR_WORDS 3456
#define XB_SPIN_CAP (1u << 18)
__device__ __forceinline__ unsigned xb_ld(unsigned* p)              { return __hip_atomic_load(p, __ATOMIC_RELAXED, __HIP_MEMORY_SCOPE_AGENT); }
__device__ __forceinline__ unsigned xb_add(unsigned* p, unsigned v) { return __hip_atomic_fetch_add(p, v, __ATOMIC_RELAXED, __HIP_MEMORY_SCOPE_AGENT); }
__device__ __forceinline__ unsigned xb_xcc_id() { return (unsigned)__builtin_amdgcn_s_getreg((3 << 11) | 20) & 0xFu; }
#define XB_SPIN(cond, bar) do { unsigned _sp = 0; while (cond) { __builtin_amdgcn_s_sleep(1); \
    if ((++_sp & 255u) == 0u) { if (xb_ld(&(bar)[XB_TMO])) break; if (_sp > XB_SPIN_CAP) { atomicAdd(&(bar)[XB_TMO], 1u); break; } } } } while (0)
struct XcdBarrier { unsigned* bar; unsigned x; volatile LAS unsigned* st; };
__device__ __forceinline__ XcdBarrier xcd_barrier_post(unsigned* bar, volatile LAS unsigned* st) {
    XcdBarrier b; b.bar = bar; b.x = xb_xcc_id(); b.st = st;
    if (threadIdx.x == 0) (void)xb_add(&bar[XB_XCNT(b.x)], 1u);
    return b;
}
__device__ __forceinline__ void xcd_barrier_complete(unsigned* bar, unsigned x, unsigned& nloc, unsigned& nx) {
    const unsigned G = gridDim.x * gridDim.y * gridDim.z;
    unsigned sum, cnt, mine, sp = 0u;
    for (;;) {
        sum = 0u; cnt = 0u; mine = 0u;
#pragma unroll
        for (unsigned j = 0; j < 16; ++j) { const unsigned c = xb_ld(&bar[XB_XCNT(j)]); sum += c; cnt += (c > 0u) ? 1u : 0u; mine = (j == x) ? c : mine; }
        if (sum == G) break;
        __builtin_amdgcn_s_sleep(1);
        if ((++sp & 255u) == 0u) { if (xb_ld(&bar[XB_TMO])) break; if (sp > XB_SPIN_CAP) { atomicAdd(&bar[XB_TMO], 1u); break; } }
    }
    nloc = mine > 0u ? mine : 1u; nx = cnt > 0u ? cnt : 1u;
}
__device__ __noinline__ void xcd_barrier(const XcdBarrier b) {
    asm volatile("s_waitcnt vmcnt(0)" ::: "memory");
    __syncthreads();
    if (threadIdx.x == 0) {
        const unsigned long long pb_ = (unsigned long long)b.bar;
        unsigned* bar = (unsigned*)(((unsigned long long)__builtin_amdgcn_readfirstlane((unsigned)(pb_ >> 32)) << 32) | (unsigned long long)__builtin_amdgcn_readfirstlane((unsigned)pb_));
        const unsigned bx_ = __builtin_amdgcn_readfirstlane(b.x);
        __builtin_amdgcn_s_waitcnt(0);
        unsigned nloc = b.st[0], nx = b.st[1];
        if (nloc == 0u) { xcd_barrier_complete(bar, bx_, nloc, nx); b.st[0] = nloc; b.st[1] = nx; }
        const unsigned old = xb_add(&bar[XB_XSUB(bx_)], 1u);
        const unsigned gen = old / nloc;
        if (old + 1u == (gen + 1u) * nloc) {
            __builtin_amdgcn_fence(__ATOMIC_RELEASE, "agent");
            asm volatile("s_waitcnt vmcnt(0)" ::: "memory");
            const unsigned og = xb_add(&bar[XB_TOP], 1u);
            const unsigned tg = og / nx;
            if (og + 1u == (tg + 1u) * nx) xb_add(&bar[XB_TOPGEN], 1u);
            else XB_SPIN(xb_ld(&bar[XB_TOPGEN]) == tg, bar);
            __builtin_amdgcn_fence(__ATOMIC_ACQUIRE, "agent");
            xb_add(&bar[XB_XGEN(bx_)], 1u);
            asm volatile("s_waitcnt vmcnt(0)" ::: "memory");
        } else {
            XB_SPIN(xb_ld(&bar[XB_XGEN(bx_)]) == gen, bar);
            __builtin_amdgcn_fence(__ATOMIC_ACQUIRE, "agent");
            asm volatile("s_waitcnt vmcnt(0)" ::: "memory");
        }
    }
    __syncthreads();
}

constexpr int RING_OFF = 0, RING_BYTES = 131072, LDSCTL_OFF = RING_BYTES, MISC_OFF = LDSCTL_OFF + 320, LDS_BYTES = 147456, NWAVES = 8;

struct Params { const float* in[N_INPUTS]; float* out; unsigned char* ws; int ph_lo, ph_hi; };
static_assert(sizeof(Params) == N_INPUTS * 8 + 8 + 8 + 8, "Params has no padding");

struct Frame {
    LAS unsigned char* lds;
    int tid, lane, wave, vcu, G, gw, NGW;
    unsigned char* ws; float* out;
};
__device__ __forceinline__ unsigned char* lw(const Frame& F, int li, size_t off) { return F.ws + WS_W + (size_t)li * LW_SIZE + off; }

__device__ __forceinline__ void transpose_item(const float* W, int ldw, int K, int c0, bf16* WT, int r0, LAS float* scr, int kb, int lane) {
    const int k0 = 64 * kb;
#pragma unroll 8
    for (int i = 0; i < 32; ++i) { const int kk = 2 * i + (lane >> 5); scr[kk * 33 + (lane & 31)] = W[(size_t)(k0 + kk) * ldw + c0 + (lane & 31)]; }
    LDS_WAIT(); asm volatile("" ::: "memory");
    const int c = lane & 7;
#pragma unroll
    for (int j = 0; j < 4; ++j) { const int n = (lane >> 3) + 8 * j; const LAS float* s = scr + (8 * c) * 33 + n;
        v4u o; o.x = pk2(s[0 * 33], s[1 * 33]); o.y = pk2(s[2 * 33], s[3 * 33]); o.z = pk2(s[4 * 33], s[5 * 33]); o.w = pk2(s[6 * 33], s[7 * 33]);
        *(GAS v4u*)(WT + (size_t)(r0 + n) * K + k0 + 8 * c) = o; }
    LDS_WAIT(); asm volatile("" ::: "memory");
}
constexpr int IT_G = 32 * 172, IT_D = 86 * 64, IT_WINH = 32 * 96, IT_WOUT = 32 * 64, IT_LAYER = 4 * IT_G + 2 * IT_D + 2 * IT_WINH + IT_WOUT;
__device__ __forceinline__ void p0_weights(const Frame& F, const Params& P) {
    LAS float* scr = (LAS float*)(F.lds + RING_OFF + F.wave * 16384);
    for (int it = F.gw; it < DEPTH * IT_LAYER; it += F.NGW) {
        const int li = it / IT_LAYER; int r = it % IT_LAYER;
        if (r < 4 * IT_G) { const int q = r / IT_G, rr = r % IT_G, kb = rr / 172, nb = rr % 172, n0 = 32 * nb;
            const float* W = P.in[(q < 2 ? I_F1WG : I_F2WG) + (q & 1)] + (size_t)li * DM * DFF;
            bf16* WT = (bf16*)lw(F, li, q < 2 ? LW_W1A : LW_W2A);
            transpose_item(W, DFF, DM, n0, WT, (n0 >> 7) * 256 + (n0 & 127) + (q & 1) * 128, scr, kb, F.lane); continue; }
        r -= 4 * IT_G;
        if (r < 2 * IT_D) { const int q = r / IT_D, rr = r % IT_D, kb = rr / 64, nb = rr % 64;
            const float* W = P.in[q ? I_F2WD : I_F1WD] + (size_t)li * DFF * DM;
            transpose_item(W, DM, DFF, 32 * nb, (bf16*)lw(F, li, q ? LW_W2D : LW_W1D), 32 * nb, scr, kb, F.lane); continue; }
        r -= 2 * IT_D;
        if (r < 2 * IT_WINH) { const int q = r / IT_WINH, rr = r % IT_WINH, kb = rr / 96, nb = rr % 96;
            transpose_item(P.in[I_WIN] + (size_t)li * DM * NIN, NIN, DM, (q ? 3080 : 0) + 32 * nb, (bf16*)lw(F, li, LW_WIN), q * 3072 + 32 * nb, scr, kb, F.lane); continue; }
        r -= 2 * IT_WINH;
        { const int kb = r / 64, nb = r % 64; transpose_item(P.in[I_WOUT] + (size_t)li * DM * DM, DM, DM, 32 * nb, (bf16*)lw(F, li, LW_WOUT), 32 * nb, scr, kb, F.lane); }
    }
    for (int i = (F.vcu * NWAVES + F.wave) * 64 + F.lane; i < DEPTH * 8 * DM; i += F.NGW * 64) { const int li = i / (8 * DM), g = (i / DM) & 7, k = i % DM;
        ((float*)lw(F, li, LW_WG))[g * DM + k] = P.in[I_WIN][(size_t)li * DM * NIN + (size_t)k * NIN + 3072 + g]; }
}

template <bool HAS_Y, bool HAS_HN, bool GATES>
__device__ __forceinline__ void row_one(const Frame& F, const float* xrow, float* Xrow, const float* yrow, const float* post_g, float scale, const float* pre_g, bf16* hnrow,
                                        const float* WG, const float* b_i, const float* b_f, float* grow) {
    const GAS f32x4* xr = (const GAS f32x4*)xrow + F.lane;
    f32x4 x[8];
#pragma unroll
    for (int j = 0; j < 8; ++j) x[j] = xr[64 * j];
    if (HAS_Y) {
        const GAS f32x4* yr = (const GAS f32x4*)yrow + F.lane; f32x4 y[8]; float s = 0.f;
#pragma unroll
        for (int j = 0; j < 8; ++j) { y[j] = yr[64 * j]; s += (y[j].x * y[j].x + y[j].y * y[j].y) + (y[j].z * y[j].z + y[j].w * y[j].w); }
        const float rs = scale * __builtin_amdgcn_rsqf(wave_sum(s) * (1.f / DM) + EPS);
#pragma unroll
        for (int j = 0; j < 8; ++j) { const f32x4 g = ((const GAS f32x4*)post_g)[F.lane + 64 * j]; x[j] = x[j] + y[j] * g * rs; }
    }
    if (HAS_Y || xrow != Xrow) {
        GAS f32x4* xo = (GAS f32x4*)Xrow + F.lane;
#pragma unroll
        for (int j = 0; j < 8; ++j) xo[64 * j] = x[j];
    }
    if (HAS_HN) {
        float s = 0.f;
#pragma unroll
        for (int j = 0; j < 8; ++j) s += (x[j].x * x[j].x + x[j].y * x[j].y) + (x[j].z * x[j].z + x[j].w * x[j].w);
        const float rs = __builtin_amdgcn_rsqf(wave_sum(s) * (1.f / DM) + EPS);
        GAS v2u* o8 = (GAS v2u*)hnrow + F.lane;
#pragma unroll
        for (int j = 0; j < 8; ++j) { const f32x4 g = ((const GAS f32x4*)pre_g)[F.lane + 64 * j]; x[j] = x[j] * g * rs; v2u w; w.x = pk2(x[j].x, x[j].y); w.y = pk2(x[j].z, x[j].w); o8[64 * j] = w; }
        if (GATES) {
            float v = 0.f;
#pragma unroll 1
            for (int g = 0; g < 8; ++g) { float a = 0.f;
#pragma unroll
                for (int j = 0; j < 8; ++j) { const f32x4 w = ((const GAS f32x4*)(WG + g * DM))[F.lane + 64 * j]; a += (x[j].x * w.x + x[j].y * w.y) + (x[j].z * w.z + x[j].w * w.w); }
                const float tot = wave_sum(a); v = (F.lane == g) ? tot : v; }
            if (F.lane < 8) {
                if (F.lane < 4) v += b_i[F.lane]; else { const float z = v + b_f[F.lane - 4]; v = fminf(z, 0.f) - log1pf(expf(-fabsf(z))); }
                grow[F.lane] = v; }
        }
    }
}
}
namespace at {
using bf16x8 = __attribute__((ext_vector_type(8))) short;
using s16x4  = __attribute__((ext_vector_type(4))) short;
using f32x16 = __attribute__((ext_vector_type(16))) float;
using f32x4  = __attribute__((ext_vector_type(4))) float;
using u32x4  = __attribute__((ext_vector_type(4))) unsigned;
using u32x2  = __attribute__((ext_vector_type(2))) unsigned;
#define KSWZ(row, colB) ((row) * 256 + ((colB) ^ (((row) & 7) << 4)))
#define SBAR() __builtin_amdgcn_sched_barrier(0)
__device__ __forceinline__ int crow(int r, int hi) { return (r & 3) + 8 * (r >> 2) + 4 * hi; }
__device__ __forceinline__ unsigned cvtpk(float lo, float hi) { unsigned r; asm volatile("v_cvt_pk_bf16_f32 %0, %1, %2" : "=v"(r) : "v"(lo), "v"(hi)); return r; }
__device__ __forceinline__ bf16x8 tobf8(f32x4 a, f32x4 b) { u32x4 w = {cvtpk(a[0], a[1]), cvtpk(a[2], a[3]), cvtpk(b[0], b[1]), cvtpk(b[2], b[3])}; return *reinterpret_cast<bf16x8*>(&w); }
__device__ __forceinline__ int v_st(int k, int c) { const int kk = (k & ~0xC) | ((k & 4) << 1) | ((k & 8) >> 1); return ((kk >> 3) * 4 + (c >> 5)) * 512 + ((kk & 7) * 32 + (c & 31)) * 2; }
__device__ __forceinline__ int v_rd_base(int lane) { return ((lane & 3) << 3) | (((lane >> 2) & 3) << 6) | (((lane >> 4) & 1) << 5) | (((lane >> 5) & 1) << 8); }
constexpr int v_rd_off(int d0, int ks, int half) { return d0 * 512 + ks * 4096 + half * 2048; }
template <int OFF> __device__ __forceinline__ s16x4 tr_read(int vb) { s16x4 r; asm volatile("ds_read_b64_tr_b16 %0, %1 offset:%2" : "=&v"(r) : "v"(vb), "i"(OFF) : "memory"); return r; }
#define AT_PK(L, H) (at::bf16x8){L[0], L[1], L[2], L[3], H[0], H[1], H[2], H[3]}
#define AT_TRFRAG_DECL(name, vb, D0, KS) const at::s16x4 name##_l = at::tr_read<at::v_rd_off(D0, KS, 0)>(vb), name##_h = at::tr_read<at::v_rd_off(D0, KS, 1)>(vb)
#define AT_PK4(P, BASE, OUT) do { unsigned a0 = at::cvtpk(P[BASE + 0], P[BASE + 1]), a1 = at::cvtpk(P[BASE + 2], P[BASE + 3]);   \
    unsigned b0 = at::cvtpk(P[BASE + 4], P[BASE + 5]), b1 = at::cvtpk(P[BASE + 6], P[BASE + 7]);                              \
    auto r0 = __builtin_amdgcn_permlane32_swap(a0, b0, false, false); auto r1 = __builtin_amdgcn_permlane32_swap(a1, b1, false, false); \
    at::u32x4 w_ = {r0[0], r1[0], r0[1], r1[1]}; OUT = *reinterpret_cast<at::bf16x8*>(&w_); } while (0)
__device__ __forceinline__ float swap_add(float x) { auto rr = __builtin_amdgcn_permlane32_swap(__float_as_uint(x), __float_as_uint(x), false, false); return __uint_as_float(rr[0]) + __uint_as_float(rr[1]); }
__device__ __forceinline__ float swap_max(float x) { auto rr = __builtin_amdgcn_permlane32_swap(__float_as_uint(x), __float_as_uint(x), false, false); return fmaxf(__uint_as_float(rr[0]), __uint_as_float(rr[1])); }
}

namespace op {
__device__ __forceinline__ void conv_phase(const Frame& F, const Params& P, int li) {
    const float* QR = (const float*)(F.ws + WS_QKRAW); bf16* QC = (bf16*)(F.ws + WS_QC);
    const float* cw = P.in[I_CONVW] + li * 4 * 1024; const float* cb = P.in[I_CONVB] + li * 1024; const float* sconv = P.in[I_SCONV] + (size_t)li * DEC_BATCH * 3 * 1024;
    for (int it = F.gw; it < (MT / 16) * 4; it += F.NGW) {
        const int rb = it >> 2, cg = it & 3, c = cg * 256 + F.lane * 4, r0 = rb * 16;
        const bool pr = r0 < MP; const int L = pr ? SEQ : DEC_SEQ, b = pr ? r0 / SEQ : (r0 - MP) / DEC_SEQ, t0 = pr ? r0 % SEQ : (r0 - MP) % DEC_SEQ;
        const f32x4 w0 = *(const GAS f32x4*)(cw + c), w1 = *(const GAS f32x4*)(cw + 1024 + c), w2 = *(const GAS f32x4*)(cw + 2048 + c), w3 = *(const GAS f32x4*)(cw + 3072 + c), bb = *(const GAS f32x4*)(cb + c);
        f32x4 xm3, xm2, xm1;
        if (t0 == 0) { if (pr) { xm3 = xm2 = xm1 = (f32x4){0.f, 0.f, 0.f, 0.f}; } else { const float* sp = sconv + (size_t)b * 3 * 1024 + c; xm3 = *(const GAS f32x4*)sp; xm2 = *(const GAS f32x4*)(sp + 1024); xm1 = *(const GAS f32x4*)(sp + 2048); } }
        else { const float* sp = QR + (size_t)(r0 - 3) * 1024 + c; xm3 = *(const GAS f32x4*)sp; xm2 = *(const GAS f32x4*)(sp + 1024); xm1 = *(const GAS f32x4*)(sp + 2048); }
        const float ksc = (c >= 512) ? 0.08838834764831845f : 1.0f;
        const bool last = (t0 + 16 == L);
        float* so = pr ? F.out + O_PCONV + ((size_t)li * BATCH + b) * 3 * 1024 + c : F.out + O_SCONV + ((size_t)li * DEC_BATCH + b) * 3 * 1024 + c;
#pragma unroll 4
        for (int i = 0; i < 16; ++i) {
            const f32x4 x0 = *(const GAS f32x4*)(QR + (size_t)(r0 + i) * 1024 + c);
            f32x4 y = bb + xm3 * w0 + xm2 * w1 + xm1 * w2 + x0 * w3;
#pragma unroll
            for (int e = 0; e < 4; ++e) { const float v = y[e]; y[e] = v * __builtin_amdgcn_rcpf(1.0f + __builtin_amdgcn_exp2f(-1.4426950408889634f * v)) * ksc; }
            v2u o; o.x = pk2(y[0], y[1]); o.y = pk2(y[2], y[3]);
            *(GAS v2u*)(QC + (size_t)(r0 + i) * 1024 + c) = o;
            if (last && i >= 13) *(GAS f32x4*)(so + (size_t)(i - 13) * 1024) = x0;
            xm3 = xm2; xm2 = xm1; xm1 = x0;
        }
    }
    const float* GT = (const float*)(F.ws + WS_GATES); float* CHK = (float*)(F.ws + WS_CHK);
    for (int it = F.gw; it < NCK * 4; it += F.NGW) {
        const int ck = it >> 2, h = it & 3, row = ck * 64 + F.lane;
        const float ig = GT[(size_t)row * 8 + h], lf = GT[(size_t)row * 8 + 4 + h];
        float bsum = lf;
#pragma unroll
        for (int o = 1; o < 64; o <<= 1) { const float t = __shfl_up(bsum, o); if (F.lane >= o) bsum += t; }
        const float g = ig - bsum; float cm = g;
#pragma unroll
        for (int o = 1; o < 64; o <<= 1) { const float t = __shfl_up(cm, o); if (F.lane >= o) cm = fmaxf(cm, t); }
        float* o = CHK + (size_t)it * CHK_STRIDE;
        o[F.lane] = bsum; o[64 + F.lane] = g; o[128 + F.lane] = cm;
        if (F.lane == 63) { o[192] = bsum; o[193] = cm; }
    }
}

__device__ __forceinline__ float mprev_of(const Frame& F, const Params& P, int li, int ck, int h) {
    if (ck >= 128) return P.in[I_SM][(size_t)li * DEC_BATCH * 4 + (ck - 128) * 4 + h];
    const int b = ck >> 6, c = ck & 63; const float* CHK = (const float*)(F.ws + WS_CHK);
    float a = 0.f, G = 0.f;
    if (F.lane < c) { const float* p = CHK + (size_t)(((b * 64 + F.lane) * 4) + h) * CHK_STRIDE; a = p[192]; G = p[193]; }
    float m = 0.f;
    for (int j = 0; j < c; ++j) { const float aj = __shfl(a, j), Gj = __shfl(G, j); m = aj + fmaxf(m, Gj); }
    return m;
}

constexpr int ML_KT = 0, ML_VT0 = 16384, ML_VT1 = 32768, ML_QR = 49152, ML_KR = 65536, ML_SC = 81920;

__device__ __forceinline__ void mlstm_dc_item(const Frame& F, const Params& P, int li, int item) {
    int lane_ = F.lane, tid_ = F.tid, wave_ = F.wave; asm volatile("" : "+v"(lane_), "+v"(tid_), "+s"(wave_));
    const int ck = item >> 2, h = item & 3, row0 = ck * 64; const bool pr = ck < 128;
    const float* chk = (const float*)(F.ws + WS_CHK) + (size_t)item * CHK_STRIDE;
    LAS float* sc = (LAS float*)(F.lds + RING_OFF + ML_SC);
    const float m_prev = mprev_of(F, P, li, ck, h);
    const float G = chk[193], a = chk[192], M_last = fmaxf(m_prev, G), decay = __expf(m_prev - M_last), m_new = a + M_last;
    if (wave_ == 0) sc[lane_] = __expf(chk[64 + lane_] - M_last);
    __syncthreads();
    const bf16* QC = (const bf16*)(F.ws + WS_QC); const bf16* MV = (const bf16*)(F.ws + WS_MLV);
#pragma unroll
    for (int i = 0; i < 2; ++i) { const int id = tid_ + 512 * i, s = id >> 4, c8 = (id & 15) * 8;
        const v4u raw = *(const GAS v4u*)(QC + (size_t)(row0 + s) * 1024 + 512 + h * 128 + c8); const float w = sc[s];
        v4u o;
#pragma unroll
        for (int e = 0; e < 4; ++e) { const unsigned u = raw[e]; o[e] = pk2(__builtin_bit_cast(float, u << 16) * w, __builtin_bit_cast(float, u & 0xffff0000u) * w); }
        *(LAS v4u*)(F.lds + RING_OFF + ML_KT + at::v_st(s, c8)) = o; }
#pragma unroll
    for (int i = 0; i < 4; ++i) { const int id = tid_ + 512 * i, s = id >> 5, c8 = (id & 31) * 8;
        const v4u raw = *(const GAS v4u*)(MV + (size_t)(row0 + s) * 1024 + h * 256 + c8);
        *(LAS v4u*)(F.lds + RING_OFF + (c8 < 128 ? ML_VT0 : ML_VT1) + at::v_st(s, c8 & 127)) = raw; }
    __syncthreads();
    float dn = 0.f;
    if (tid_ < 128) { for (int s = 0; s < 64; ++s) dn += bf2f(*(const LAS unsigned short*)(F.lds + RING_OFF + ML_KT + at::v_st(s, tid_))); }
    const int vbV = (int)(uintptr_t)(F.lds + RING_OFF + (wave_ < 4 ? ML_VT0 : ML_VT1)) + at::v_rd_base(lane_), vbK = (int)(uintptr_t)(F.lds + RING_OFF + ML_KT) + at::v_rd_base(lane_);
    at::f32x16 acc[4] = {};
#define DC_STEP(KS) do { \
        at::s16x4 al, ah; \
        switch (wave_ & 3) { case 0: al = at::tr_read<at::v_rd_off(0, KS, 0)>(vbV); ah = at::tr_read<at::v_rd_off(0, KS, 1)>(vbV); break; \
                              case 1: al = at::tr_read<at::v_rd_off(1, KS, 0)>(vbV); ah = at::tr_read<at::v_rd_off(1, KS, 1)>(vbV); break; \
                              case 2: al = at::tr_read<at::v_rd_off(2, KS, 0)>(vbV); ah = at::tr_read<at::v_rd_off(2, KS, 1)>(vbV); break; \
                              default: al = at::tr_read<at::v_rd_off(3, KS, 0)>(vbV); ah = at::tr_read<at::v_rd_off(3, KS, 1)>(vbV); break; } \
        AT_TRFRAG_DECL(b0, vbK, 0, KS); AT_TRFRAG_DECL(b1, vbK, 1, KS); AT_TRFRAG_DECL(b2, vbK, 2, KS); AT_TRFRAG_DECL(b3, vbK, 3, KS); \
        asm volatile("s_waitcnt lgkmcnt(0)" ::: "memory"); SBAR(); \
        const at::bf16x8 af = AT_PK(al, ah); \
        acc[0] = __builtin_amdgcn_mfma_f32_32x32x16_bf16(af, AT_PK(b0_l, b0_h), acc[0], 0, 0, 0); \
        acc[1] = __builtin_amdgcn_mfma_f32_32x32x16_bf16(af, AT_PK(b1_l, b1_h), acc[1], 0, 0, 0); \
        acc[2] = __builtin_amdgcn_mfma_f32_32x32x16_bf16(af, AT_PK(b2_l, b2_h), acc[2], 0, 0, 0); \
        acc[3] = __builtin_amdgcn_mfma_f32_32x32x16_bf16(af, AT_PK(b3_l, b3_h), acc[3], 0, 0, 0); } while (0)
    DC_STEP(0); DC_STEP(1); DC_STEP(2); DC_STEP(3);
#undef DC_STEP
    const int r32 = lane_ & 31, hi = lane_ >> 5;
    if (pr) {
        const int idx = item;
        float* p = (float*)(F.ws + WS_DC) + (size_t)idx * 32768 + (size_t)(32 * wave_ + 4 * hi) * 128 + r32;
#pragma unroll
        for (int r = 0; r < 16; ++r) {
#pragma unroll
            for (int j = 0; j < 4; ++j) p[32 * j] = acc[j][r];
            p += ((r & 3) == 3) ? 5 * 128 : 128; asm volatile("" : "+v"(p)); }
        if (tid_ < 128) ((float*)(F.ws + WS_DN))[(size_t)idx * 128 + tid_] = dn;
        if (tid_ == 0) { float* s4 = (float*)(F.ws + WS_SC) + (size_t)idx * 4; s4[0] = decay; s4[1] = m_new; s4[2] = m_prev; s4[3] = 0.f; }
    } else {
        const int b = ck - 128; const size_t sidx = ((size_t)li * DEC_BATCH + b) * 4 + h;
        const size_t o0 = sidx * 32768 + (size_t)(32 * wave_ + 4 * hi) * 128 + r32;
        const float* ci = P.in[I_SC] + o0; float* co = F.out + O_SC + o0;
#pragma unroll
        for (int r = 0; r < 16; ++r) {
#pragma unroll
            for (int j = 0; j < 4; ++j) co[32 * j] = decay * ci[32 * j] + acc[j][r];
            const int d = ((r & 3) == 3) ? 5 * 128 : 128; ci += d; co += d; asm volatile("" : "+v"(ci), "+v"(co)); }
        if (tid_ < 128) F.out[O_SN + sidx * 128 + tid_] = decay * P.in[I_SN][sidx * 128 + tid_] + dn;
        if (tid_ == 0) F.out[O_SM + sidx] = m_new;
    }
    __syncthreads();
}

__device__ __forceinline__ void mlstm_scan_phase(const Frame& F, const Params& P, int li) {
    const int gt = F.vcu * (NWAVES * 64) + F.tid, NT = F.G * NWAVES * 64;
    const float* SC = (const float*)(F.ws + WS_SC);
    for (int e = gt; e < 8 * 8192 + 8 * 32; e += NT) {
        const bool isC = e < 8 * 8192; const int bh = isC ? e >> 13 : (e - 8 * 8192) >> 5, q = isC ? e & 8191 : (e - 8 * 8192) & 31, b = bh >> 2, h = bh & 3;
        GAS f32x4* base = isC ? (GAS f32x4*)((float*)(F.ws + WS_DC)) + q : (GAS f32x4*)((float*)(F.ws + WS_DN)) + q; const size_t stride = isC ? 8192 : 32;
        f32x4 C = {0.f, 0.f, 0.f, 0.f};
        for (int c0 = 0; c0 < 64; c0 += 8) { f32x4 t[8]; float dc[8];
#pragma unroll
            for (int i = 0; i < 8; ++i) { const size_t idx = (size_t)((b * 64 + c0 + i) * 4 + h); t[i] = base[idx * stride]; dc[i] = SC[idx * 4]; }
#pragma unroll
            for (int i = 0; i < 8; ++i) { const size_t idx = (size_t)((b * 64 + c0 + i) * 4 + h); base[idx * stride] = C; C = C * dc[i] + t[i]; } }
        const size_t sidx = ((size_t)li * BATCH + b) * 4 + h;
        if (isC) *((GAS f32x4*)(F.out + O_PC + sidx * 32768) + q) = C; else *((GAS f32x4*)(F.out + O_PN + sidx * 128) + q) = C;
    }
    if (gt < 8) { const int b = gt >> 2, h = gt & 3; F.out[O_PM + ((size_t)li * BATCH + b) * 4 + h] = SC[(size_t)((b * 64 + 63) * 4 + h) * 4 + 1]; }
}

__device__ __forceinline__ void mlstm_h_item(const Frame& F, const Params& P, int li, int item) {
    int lane_ = F.lane, tid_ = F.tid, wave_ = F.wave; asm volatile("" : "+v"(lane_), "+v"(tid_), "+s"(wave_));
    const int ck = item >> 2, h = item & 3, row0 = ck * 64; const bool pr = ck < 128;
    const float* chk = (const float*)(F.ws + WS_CHK) + (size_t)item * CHK_STRIDE;
    LAS float* sc = (LAS float*)(F.lds + RING_OFF + ML_SC);
    const int r32 = lane_ & 31, hi = lane_ >> 5;
    float m_prev; const float* Cst; const float* nst;
    if (pr) { m_prev = ((const float*)(F.ws + WS_SC))[(size_t)item * 4 + 2]; Cst = (const float*)(F.ws + WS_DC) + (size_t)item * 32768; nst = (const float*)(F.ws + WS_DN) + (size_t)item * 128; }
    else { const size_t sidx = ((size_t)li * DEC_BATCH + (ck - 128)) * 4 + h; m_prev = P.in[I_SM][sidx]; Cst = P.in[I_SC] + sidx * 32768; nst = P.in[I_SN] + sidx * 128; }
    if (tid_ < 192) sc[tid_] = chk[(tid_ < 64) ? 64 + tid_ : (tid_ < 128 ? tid_ - 64 : tid_)];
    if (tid_ >= 256 && tid_ < 384) sc[tid_] = nst[tid_ - 256];
    const bf16* QC = (const bf16*)(F.ws + WS_QC); const bf16* MV = (const bf16*)(F.ws + WS_MLV);
#pragma unroll
    for (int i = 0; i < 2; ++i) { const int id = tid_ + 512 * i, s = id >> 4, c8 = (id & 15) * 8;
        *(LAS v4u*)(F.lds + RING_OFF + ML_QR + KSWZ(s, c8 * 2)) = *(const GAS v4u*)(QC + (size_t)(row0 + s) * 1024 + h * 128 + c8);
        *(LAS v4u*)(F.lds + RING_OFF + ML_KR + KSWZ(s, c8 * 2)) = *(const GAS v4u*)(QC + (size_t)(row0 + s) * 1024 + 512 + h * 128 + c8); }
#pragma unroll
    for (int i = 0; i < 4; ++i) { const int id = tid_ + 512 * i, s = id >> 5, c8 = (id & 31) * 8;
        *(LAS v4u*)(F.lds + RING_OFF + (c8 < 128 ? ML_VT0 : ML_VT1) + at::v_st(s, c8 & 127)) = *(const GAS v4u*)(MV + (size_t)(row0 + s) * 1024 + h * 256 + c8); }
    at::bf16x8 cf[8];
    { const float* cr = Cst + (size_t)(32 * wave_ + r32) * 128 + hi * 8;
#pragma unroll
      for (int d0 = 0; d0 < 8; ++d0) { const f32x4 lo = *(const GAS f32x4*)(cr + d0 * 16), hi4 = *(const GAS f32x4*)(cr + d0 * 16 + 4); cf[d0] = at::tobf8(lo, hi4); } }
    __syncthreads();
    const LAS unsigned char* Qr = F.lds + RING_OFF + ML_QR; const LAS unsigned char* Kr = F.lds + RING_OFF + ML_KR;
    LAS float* wsc = sc + 512 + 128 * wave_;
    const int vbV = (int)(uintptr_t)(F.lds + RING_OFF + (wave_ < 4 ? ML_VT0 : ML_VT1)) + at::v_rd_base(lane_);
#pragma unroll
    for (int tb = 0; tb < 2; ++tb) {
        const int t = 32 * tb + r32;
        at::bf16x8 qf[8];
#pragma unroll
        for (int d0 = 0; d0 < 8; ++d0) qf[d0] = *(const LAS at::bf16x8*)(Qr + KSWZ(t, (d0 * 16 + hi * 8) * 2));
        at::f32x16 p0 = {}, p1 = {};
#pragma unroll
        for (int d0 = 0; d0 < 8; ++d0) { const int cb = (d0 * 16 + hi * 8) * 2;
            const at::bf16x8 k0 = *(const LAS at::bf16x8*)(Kr + KSWZ(r32, cb)), k1 = *(const LAS at::bf16x8*)(Kr + KSWZ(32 + r32, cb));
            p0 = __builtin_amdgcn_mfma_f32_32x32x16_bf16(k0, qf[d0], p0, 0, 0, 0);
            p1 = __builtin_amdgcn_mfma_f32_32x32x16_bf16(k1, qf[d0], p1, 0, 0, 0); }
        const float Mt = fmaxf(m_prev, sc[128 + t]), mt = sc[64 + t] + Mt;
        const float winter = __expf(m_prev - Mt);
        float dsum = 0.f;
#pragma unroll
        for (int r = 0; r < 16; ++r) { const int s0 = at::crow(r, hi), s1 = 32 + s0;
            const float w0 = (s0 <= t) ? __expf(sc[s0] - Mt) : 0.f, w1 = (s1 <= t) ? __expf(sc[s1] - Mt) : 0.f;
            p0[r] *= w0; p1[r] *= w1; dsum += p0[r] + p1[r]; }
        dsum = at::swap_add(dsum);
        float nq = 0.f;
#pragma unroll
        for (int d0 = 0; d0 < 8; ++d0)
#pragma unroll
            for (int j = 0; j < 8; ++j) nq += bf2f((unsigned short)qf[d0][j]) * sc[256 + d0 * 16 + hi * 8 + j];
        nq = at::swap_add(nq);
        const float den = dsum + winter * nq;
        const float rden = 1.0f / fmaxf(fabsf(den), __expf(-mt));
        if (hi == 0) { wsc[r32] = winter; wsc[32 + r32] = rden; }
        at::bf16x8 pa0, pa1, pa2, pa3;
        AT_PK4(p0, 0, pa0); AT_PK4(p0, 8, pa1); AT_PK4(p1, 0, pa2); AT_PK4(p1, 8, pa3);
        at::f32x16 o = {};
#pragma unroll
        for (int d0 = 0; d0 < 8; ++d0) o = __builtin_amdgcn_mfma_f32_32x32x16_bf16(qf[d0], cf[d0], o, 0, 0, 0);
        asm volatile("s_waitcnt lgkmcnt(0)" ::: "memory");
#pragma unroll
        for (int r = 0; r < 16; ++r) o[r] *= wsc[at::crow(r, hi)];
#define MH_STEP(KS, PA) do { \
        at::s16x4 vl, vh; \
        switch (wave_ & 3) { case 0: vl = at::tr_read<at::v_rd_off(0, KS, 0)>(vbV); vh = at::tr_read<at::v_rd_off(0, KS, 1)>(vbV); break; \
                              case 1: vl = at::tr_read<at::v_rd_off(1, KS, 0)>(vbV); vh = at::tr_read<at::v_rd_off(1, KS, 1)>(vbV); break; \
                              case 2: vl = at::tr_read<at::v_rd_off(2, KS, 0)>(vbV); vh = at::tr_read<at::v_rd_off(2, KS, 1)>(vbV); break; \
                              default: vl = at::tr_read<at::v_rd_off(3, KS, 0)>(vbV); vh = at::tr_read<at::v_rd_off(3, KS, 1)>(vbV); break; } \
        asm volatile("s_waitcnt lgkmcnt(0)" ::: "memory"); SBAR(); \
        o = __builtin_amdgcn_mfma_f32_32x32x16_bf16(PA, AT_PK(vl, vh), o, 0, 0, 0); } while (0)
        MH_STEP(0, pa0); MH_STEP(1, pa1); MH_STEP(2, pa2); MH_STEP(3, pa3);
#undef MH_STEP
        float* hp = (float*)(F.ws + WS_HML) + (size_t)(row0 + 32 * tb + 4 * hi) * 1024 + h * 256 + 32 * wave_ + r32;
#pragma unroll
        for (int r = 0; r < 16; ++r) { *hp = o[r] * wsc[32 + at::crow(r, hi)]; hp += ((r & 3) == 3) ? 5 * 1024 : 1024; asm volatile("" : "+v"(hp)); }
        asm volatile("s_waitcnt lgkmcnt(0)" ::: "memory");
    }
    __syncthreads();
}
}
namespace wsx {}
namespace op {
constexpr size_t WS_ATTO = WS_END2;
constexpr size_t WS_SATT = WS_ATTO + (size_t)2 * MT * 1024 * 4;
constexpr size_t WS_SML = WS_SATT + (size_t)4 * MS * 1024 * 4;
constexpr size_t WS_MIX = WS_SML + (size_t)4 * MS * 4 * 2 * 4;
constexpr size_t WS_END3 = WS_MIX + (size_t)MT * DM * 2;
static_assert(WS_ATTO % 256 == 0 && WS_SATT % 256 == 0 && WS_SML % 256 == 0 && WS_MIX % 256 == 0, "ws alignment 3");
}
namespace at {
constexpr float SCALE = 0.088388347648318440f;
constexpr float THR = 8.f;
constexpr int SHM_V = 64 * 128 * 2, SHM_K = 64 * 128 * 2;
__device__ __forceinline__ void partialSM(f32x16& p0, f32x16& p1, float& m_reg, float& mn, float& alpha) {
  constexpr float C = SCALE * 1.4426950408889634f;
  float pmax = p0[0];
#pragma unroll
  for (int r = 1; r < 16; ++r) pmax = fmaxf(pmax, p0[r]);
#pragma unroll
  for (int r = 0; r < 16; ++r) pmax = fmaxf(pmax, p1[r]);
  { auto rr = __builtin_amdgcn_permlane32_swap(__float_as_uint(pmax), __float_as_uint(pmax), false, false);
    pmax = fmaxf(__uint_as_float(rr[0]), __uint_as_float(rr[1])); }
  if (__builtin_expect(__all(pmax - m_reg <= THR / SCALE), 1)) { mn = m_reg; alpha = 1.f; }
  else { mn = fmaxf(m_reg, pmax); alpha = __builtin_amdgcn_exp2f((m_reg - mn) * C); m_reg = mn; }
  float mnC = -mn * C;
#pragma unroll
  for (int r = 0; r < 16; ++r) p0[r] = fmaf(p0[r], C, mnC);
#pragma unroll
  for (int r = 0; r < 16; ++r) p1[r] = fmaf(p1[r], C, mnC);
#pragma unroll
  for (int r = 0; r < 16; ++r) p0[r] = __builtin_amdgcn_exp2f(p0[r]);
}
__device__ __forceinline__ void finishSM(f32x16& p0, f32x16& p1, float alpha, float& l_reg, bf16x8& pa0, bf16x8& pa1, bf16x8& pa2, bf16x8& pa3) {
#pragma unroll
  for (int r = 0; r < 16; ++r) p1[r] = __builtin_amdgcn_exp2f(p1[r]);
  float ps = 0;
#pragma unroll
  for (int r = 0; r < 16; ++r) ps += p0[r];
#pragma unroll
  for (int r = 0; r < 16; ++r) ps += p1[r];
  { auto rr = __builtin_amdgcn_permlane32_swap(__float_as_uint(ps), __float_as_uint(ps), false, false);
    ps = __uint_as_float(rr[0]) + __uint_as_float(rr[1]); }
  l_reg = l_reg * alpha + ps;
  AT_PK4(p0, 0, pa0); AT_PK4(p0, 8, pa1); AT_PK4(p1, 0, pa2); AT_PK4(p1, 8, pa3);
}
typedef __attribute__((address_space(3))) unsigned char lds_u8;
__device__ __forceinline__ void qkt(f32x16& p0, f32x16& p1, const lds_u8* Ks, const bf16x8* qr, int r32, int hi) {
  p0 = f32x16{}; p1 = f32x16{};
#pragma unroll
  for (int d0 = 0; d0 < 8; ++d0) { int cb = (d0 * 16 + hi * 8) * 2;
    bf16x8 b0 = *reinterpret_cast<const __attribute__((address_space(3))) bf16x8*>(Ks + KSWZ(r32, cb));
    bf16x8 b1 = *reinterpret_cast<const __attribute__((address_space(3))) bf16x8*>(Ks + KSWZ(32 + r32, cb));
    p0 = __builtin_amdgcn_mfma_f32_32x32x16_bf16(b0, qr[d0], p0, 0, 0, 0);
    p1 = __builtin_amdgcn_mfma_f32_32x32x16_bf16(b1, qr[d0], p1, 0, 0, 0); }
}
template <int D0> __device__ __forceinline__ void pv_one(f32x16& od, int vb, bf16x8 pa0, bf16x8 pa1, bf16x8 pa2, bf16x8 pa3) {
  const s16x4 l0 = tr_read<v_rd_off(D0, 0, 0)>(vb), h0 = tr_read<v_rd_off(D0, 0, 1)>(vb), l1 = tr_read<v_rd_off(D0, 1, 0)>(vb), h1 = tr_read<v_rd_off(D0, 1, 1)>(vb);
  const s16x4 l2 = tr_read<v_rd_off(D0, 2, 0)>(vb), h2 = tr_read<v_rd_off(D0, 2, 1)>(vb), l3 = tr_read<v_rd_off(D0, 3, 0)>(vb), h3 = tr_read<v_rd_off(D0, 3, 1)>(vb);
  asm volatile("s_waitcnt lgkmcnt(0)" ::: "memory"); SBAR();
  od = __builtin_amdgcn_mfma_f32_32x32x16_bf16(pa0, AT_PK(l0, h0), od, 0, 0, 0);
  od = __builtin_amdgcn_mfma_f32_32x32x16_bf16(pa1, AT_PK(l1, h1), od, 0, 0, 0);
  od = __builtin_amdgcn_mfma_f32_32x32x16_bf16(pa2, AT_PK(l2, h2), od, 0, 0, 0);
  od = __builtin_amdgcn_mfma_f32_32x32x16_bf16(pa3, AT_PK(l3, h3), od, 0, 0, 0);
}
__device__ __forceinline__ void pv_d0(f32x16* o, int vb, bf16x8 pa0, bf16x8 pa1, bf16x8 pa2, bf16x8 pa3) {
  pv_one<0>(o[0], vb, pa0, pa1, pa2, pa3); pv_one<1>(o[1], vb, pa0, pa1, pa2, pa3); pv_one<2>(o[2], vb, pa0, pa1, pa2, pa3); pv_one<3>(o[3], vb, pa0, pa1, pa2, pa3);
}

__device__ __forceinline__ void attn_prompt_unit(lds_u8* lds, const unsigned short* Qb, const unsigned short* Kh, const unsigned short* Vh, float* Ob, int NT, int tid, int wid) {
  constexpr int LDQ = 1024, LDK = 1024, LDO = 1024;
  const int lane = tid & 63, r32 = lane & 31, hi = lane >> 5;
  lds_u8* V_lds = lds; lds_u8* K_lds = lds + 2 * SHM_V;
  __attribute__((address_space(3))) float* ws = (__attribute__((address_space(3))) float*)(lds + 2 * SHM_V + 2 * SHM_K) + wid * 64;
  __attribute__((address_space(3))) float* li_l = ws; __attribute__((address_space(3))) float* al_l = ws + 32;
  float m_reg = -1e30f, l_reg = 0; f32x16 o[4] = {}; bf16x8 qr[8];
  const unsigned short* Qw = Qb + (long)(wid * 32 + r32) * LDQ + hi * 8;
#pragma unroll
  for (int d0 = 0; d0 < 8; ++d0) qr[d0] = *reinterpret_cast<const bf16x8*>(Qw + d0 * 16);
  const int sr = tid >> 4, sc = (tid & 15) * 8, vst0 = v_st(sr, sc), vst1 = v_st(32 + sr, sc);
  const int vb0 = (int)(uintptr_t)V_lds + v_rd_base(lane);
  constexpr int SDEPTH = 1;
  struct { bf16x8 vs0, vs1, ks0, ks1; } sr_[SDEPTH];
  const unsigned voff0 = (unsigned)(sr * LDK + sc) * 2u, voff1 = voff0 + 32u * LDK * 2u;
#define SLOAD(i, k0) do { const char* vb_ = (const char*)(Vh + (long)(k0) * LDK); const char* kb_ = (const char*)(Kh + (long)(k0) * LDK); \
    sr_[i].vs0 = *reinterpret_cast<const bf16x8*>(vb_ + voff0); sr_[i].vs1 = *reinterpret_cast<const bf16x8*>(vb_ + voff1); \
    sr_[i].ks0 = *reinterpret_cast<const bf16x8*>(kb_ + voff0); sr_[i].ks1 = *reinterpret_cast<const bf16x8*>(kb_ + voff1); } while (0)
#define SWRITE(b, i) do { *(__attribute__((address_space(3))) bf16x8*)(V_lds + (b) * SHM_V + vst0) = sr_[i].vs0;          \
    *(__attribute__((address_space(3))) bf16x8*)(V_lds + (b) * SHM_V + vst1) = sr_[i].vs1; int kc = sc * 2;               \
    *(__attribute__((address_space(3))) bf16x8*)(K_lds + (b) * SHM_K + KSWZ(sr, kc)) = sr_[i].ks0;                       \
    *(__attribute__((address_space(3))) bf16x8*)(K_lds + (b) * SHM_K + KSWZ(32 + sr, kc)) = sr_[i].ks1; } while (0)
#define SWAIT() do { if constexpr (SDEPTH == 2) asm volatile("s_waitcnt vmcnt(4)" ::: "memory"); else asm volatile("s_waitcnt vmcnt(0)" ::: "memory"); } while (0)
#define RESC(a) do { if (__any((a) < 1.f)) { if (hi == 0) al_l[r32] = (a); asm volatile("s_waitcnt lgkmcnt(0)" ::: "memory"); \
    _Pragma("unroll") for (int d = 0; d < 4; ++d) _Pragma("unroll") for (int r = 0; r < 16; ++r) o[d][r] *= al_l[crow(r, hi)]; } } while (0)
#define CMASK(P0, P1, JT) do { if ((JT) >= NT - 4 && ((JT) - (NT - 4)) > (wid >> 1)) { _Pragma("unroll") for (int r = 0; r < 16; ++r) { P0[r] = -1e30f; P1[r] = -1e30f; } } } while (0)
  f32x16 pA0, pA1, pB0, pB1; float mnA, mnB, alA, alB; bf16x8 pa0, pa1, pa2, pa3;
  constexpr int SE = 0, SO = SDEPTH - 1;
  SLOAD(SE, 0); asm volatile("s_waitcnt vmcnt(0)" ::: "memory"); SWRITE(0, SE); __syncthreads();
  qkt(pA0, pA1, K_lds, qr, r32, hi); CMASK(pA0, pA1, 0); partialSM(pA0, pA1, m_reg, mnA, alA);
  SLOAD(SO, 64); if constexpr (SDEPTH == 2) { if (2 < NT) SLOAD(SE, 2 * 64); }
  SWAIT(); SWRITE(1, SO); __syncthreads();
  for (int j = 1; j + 1 < NT; j += 2) {
    SBAR(); qkt(pB0, pB1, K_lds + SHM_K, qr, r32, hi); CMASK(pB0, pB1, j);
    finishSM(pA0, pA1, alA, l_reg, pa0, pa1, pa2, pa3); SBAR();
    SLOAD(SO, (j + SDEPTH) * 64); SBAR();
    pv_d0(o, vb0, pa0, pa1, pa2, pa3); partialSM(pB0, pB1, m_reg, mnB, alB);
    __syncthreads(); SWAIT(); SWRITE(0, SE);
    RESC(alB); __syncthreads();
    SBAR(); qkt(pA0, pA1, K_lds, qr, r32, hi); CMASK(pA0, pA1, j + 1);
    finishSM(pB0, pB1, alB, l_reg, pa0, pa1, pa2, pa3); SBAR();
    if (SDEPTH == 1 || j + 3 < NT) SLOAD(SE, (j + 1 + SDEPTH) * 64); SBAR();
    pv_d0(o, vb0 + SHM_V, pa0, pa1, pa2, pa3); partialSM(pA0, pA1, m_reg, mnA, alA);
    __syncthreads(); SWAIT(); SWRITE(1, SO);
    RESC(alA); __syncthreads();
  }
  SBAR(); qkt(pB0, pB1, K_lds + SHM_K, qr, r32, hi); CMASK(pB0, pB1, NT - 1);
  finishSM(pA0, pA1, alA, l_reg, pa0, pa1, pa2, pa3); SBAR();
  pv_d0(o, vb0, pa0, pa1, pa2, pa3); partialSM(pB0, pB1, m_reg, mnB, alB);
  __syncthreads(); RESC(alB);
  finishSM(pB0, pB1, alB, l_reg, pa0, pa1, pa2, pa3); SBAR();
  pv_d0(o, vb0 + SHM_V, pa0, pa1, pa2, pa3);
  if (hi == 0) li_l[r32] = l_reg; asm volatile("s_waitcnt lgkmcnt(0)" ::: "memory");
  float* Ow = Ob + (long)(wid * 32 + 4 * hi) * LDO + r32;
#pragma unroll
  for (int r = 0; r < 16; ++r) { const float rl = __builtin_amdgcn_rcpf(li_l[crow(r, hi)]);
#pragma unroll
    for (int d0 = 0; d0 < 4; ++d0) Ow[d0 * 32] = o[d0][r] * rl;
    Ow += ((r & 3) == 3) ? 5 * LDO : LDO; asm volatile("" : "+v"(Ow)); }
  __syncthreads();
#undef SLOAD
#undef SWRITE
#undef SWAIT
#undef CMASK
}
}

namespace op {
__device__ __forceinline__ void attn_prompt_pair(const Frame& F, int p) {
    int tid_ = F.tid, wave_ = F.wave; asm volatile("" : "+v"(tid_), "+s"(wave_));
    const int combo = p >> 3, ql = p & 7, b = combo >> 4, h = (combo >> 2) & 3, s = (combo >> 1) & 1, vh = combo & 1;
    const bf16* Q = (const bf16*)(F.ws + WS_DAQ) + (size_t)b * SEQ * 1024 + h * 256 + s * 128;
    const bf16* K = (const bf16*)(F.ws + WS_DAK) + (size_t)b * SEQ * 1024 + h * 256 + s * 128;
    const bf16* V = (const bf16*)(F.ws + WS_DAV) + (size_t)b * SEQ * 1024 + h * 256 + vh * 128;
    float* O = (float*)(F.ws + WS_ATTO) + ((size_t)s * MT + (size_t)b * SEQ) * 1024 + h * 256 + vh * 128;
#pragma unroll 1
    for (int k = 0; k < 2; ++k) { const int qb = k ? ql : 15 - ql;
        at::attn_prompt_unit(F.lds + RING_OFF, Q + (size_t)qb * 256 * 1024, K, V, O + (size_t)qb * 256 * 1024, 4 * (qb + 1), tid_, wave_); }
}

constexpr int SA_K0 = 0, SA_V0 = 32768, SA_SCR = 65536;
__device__ __forceinline__ void attn_sample_item(const Frame& F, const Params& P, int li, int item) {
    int tid_ = F.tid, wave_ = F.wave; asm volatile("" : "+v"(tid_), "+s"(wave_));
    const int lane = tid_ & 63, r32 = lane & 31, hi = lane >> 5;
    const int split = item & 1, b = item >> 3, h = (item >> 1) & 3, t_lo = split ? 17 : 0, t_hi = split ? 33 : 17;
    const int s = wave_ & 1, vh = (wave_ >> 1) & 1, qg = wave_ >> 2;
    at::lds_u8* L = F.lds + RING_OFF;
    LAS float* al_l = (LAS float*)(L + SA_SCR) + wave_ * 64;
    const float* ck = P.in[I_CK] + ((size_t)(li * DEC_BATCH + b) * PAST) * 1024 + h * 256 + lane * 4;
    const float* cv = P.in[I_CV] + ((size_t)(li * DEC_BATCH + b) * PAST) * 1024 + h * 256 + lane * 4;
    const float* nk = F.out + O_SK + ((size_t)li * MS + b * 64) * 1024 + h * 256 + lane * 4;
    const float* nv = F.out + O_SV + ((size_t)li * MS + b * 64) * 1024 + h * 256 + lane * 4;
    at::bf16x8 qr[8];
    { const bf16* Qw = (const bf16*)(F.ws + WS_DAQ) + (size_t)(MP + b * 64 + qg * 32 + r32) * 1024 + h * 256 + s * 128 + hi * 8;
#pragma unroll
      for (int d0 = 0; d0 < 8; ++d0) qr[d0] = *reinterpret_cast<const at::bf16x8*>(Qw + d0 * 16); }
    const int img = lane >> 5, colw = (lane * 4) & 127;
    const at::lds_u8* Ks = L + SA_K0 + s * 16384;
    const int vb = (int)(uintptr_t)(L + SA_V0 + vh * 16384) + at::v_rd_base(lane);
    float m_reg = -1e30f, l_reg = 0.f; at::f32x16 o[4] = {};
    f32x4 kr[8];
    { const float* src = (t_lo < 32) ? ck + (size_t)(t_lo * 64 + wave_ * 8) * 1024 : nk + (size_t)(wave_ * 8) * 1024;
#pragma unroll
      for (int i = 0; i < 8; ++i) kr[i] = *(const GAS f32x4*)(src + (size_t)i * 1024); }
    for (int t = t_lo; t < t_hi; ++t) {
#pragma unroll
        for (int i = 0; i < 8; ++i) { v2u w; w.x = at::cvtpk(kr[i][0], kr[i][1]); w.y = at::cvtpk(kr[i][2], kr[i][3]);
            *(LAS v2u*)(L + SA_K0 + img * 16384 + KSWZ(wave_ * 8 + i, colw * 2)) = w; }
        f32x4 vr[8];
        { const float* src = (t < 32) ? cv + (size_t)(t * 64 + wave_ * 8) * 1024 : nv + (size_t)(wave_ * 8) * 1024;
#pragma unroll
          for (int i = 0; i < 8; ++i) vr[i] = *(const GAS f32x4*)(src + (size_t)i * 1024); }
        __syncthreads();
        at::f32x16 p0, p1; float mn, al; at::bf16x8 pa0, pa1, pa2, pa3;
        at::qkt(p0, p1, Ks, qr, r32, hi);
        at::partialSM(p0, p1, m_reg, mn, al);
        if (__any(al < 1.f)) { if (hi == 0) al_l[r32] = al; asm volatile("s_waitcnt lgkmcnt(0)" ::: "memory");
#pragma unroll
            for (int d = 0; d < 4; ++d)
#pragma unroll
                for (int r = 0; r < 16; ++r) o[d][r] *= al_l[at::crow(r, hi)]; }
        at::finishSM(p0, p1, al, l_reg, pa0, pa1, pa2, pa3);
#pragma unroll
        for (int i = 0; i < 8; ++i) { v2u w; w.x = at::cvtpk(vr[i][0], vr[i][1]); w.y = at::cvtpk(vr[i][2], vr[i][3]);
            *(LAS v2u*)(L + SA_V0 + img * 16384 + at::v_st(wave_ * 8 + i, colw)) = w; }
        if (t + 1 < t_hi) { const float* src = (t + 1 < 32) ? ck + (size_t)((t + 1) * 64 + wave_ * 8) * 1024 : nk + (size_t)(wave_ * 8) * 1024;
#pragma unroll
            for (int i = 0; i < 8; ++i) kr[i] = *(const GAS f32x4*)(src + (size_t)i * 1024); }
        __syncthreads();
        at::pv_d0(o, vb, pa0, pa1, pa2, pa3);
    }
    const int row = b * 64 + qg * 32;
    float* Op = (float*)(F.ws + WS_SATT) + ((size_t)(split * 2 + s) * MS + row + 4 * hi) * 1024 + h * 256 + vh * 128 + r32;
#pragma unroll
    for (int r = 0; r < 16; ++r) {
#pragma unroll
        for (int d0 = 0; d0 < 4; ++d0) Op[d0 * 32] = o[d0][r];
        Op += ((r & 3) == 3) ? 5 * 1024 : 1024; asm volatile("" : "+v"(Op)); }
    if (vh == 0 && hi == 0) { float* ml = (float*)(F.ws + WS_SML) + (((size_t)(split * 2 + s) * MS + row + r32) * 4 + h) * 2; ml[0] = m_reg; ml[1] = l_reg; }
    __syncthreads();
}

__device__ __forceinline__ void comb_phase(const Frame& F, const Params& P, int li) {
    const int lane = F.lane;
    float lam;
    { float a = P.in[I_LQ1][li * 128 + lane] * P.in[I_LK1][li * 128 + lane] + P.in[I_LQ1][li * 128 + 64 + lane] * P.in[I_LK1][li * 128 + 64 + lane];
      float c = P.in[I_LQ2][li * 128 + lane] * P.in[I_LK2][li * 128 + lane] + P.in[I_LQ2][li * 128 + 64 + lane] * P.in[I_LK2][li * 128 + 64 + lane];
      lam = __expf(wave_sum(a)) - __expf(wave_sum(c)) + lam_init_of(li); }
    const float oml = 1.f - lam_init_of(li);
    const float* mlg = P.in[I_MLG] + li * 1024; const float* dag = P.in[I_DAG] + li * 256;
    constexpr float C = at::SCALE * 1.4426950408889634f;
    for (int r = F.gw; r < MT; r += F.NGW) {
        bf16* mix = (bf16*)(F.ws + WS_MIX) + (size_t)r * DM;
        { f32x4 g[4]; float ss = 0.f;
#pragma unroll
          for (int j = 0; j < 4; ++j) { const int c = 4 * lane + 256 * j; const f32x4 hv = *(const GAS f32x4*)((const float*)(F.ws + WS_HML) + (size_t)r * 1024 + c);
              const v2u ob = *(const GAS v2u*)((const bf16*)(F.ws + WS_MLO) + (size_t)r * 1024 + c);
              const float o0 = __builtin_bit_cast(float, ob.x << 16), o1 = __builtin_bit_cast(float, ob.x & 0xffff0000u), o2 = __builtin_bit_cast(float, ob.y << 16), o3 = __builtin_bit_cast(float, ob.y & 0xffff0000u);
              g[j] = (f32x4){hv.x * pg8::fast_sigm(o0), hv.y * pg8::fast_sigm(o1), hv.z * pg8::fast_sigm(o2), hv.w * pg8::fast_sigm(o3)};
              ss += (g[j].x * g[j].x + g[j].y * g[j].y) + (g[j].z * g[j].z + g[j].w * g[j].w); }
          const float rs = __builtin_amdgcn_rsqf(wave_sum(ss) * (1.f / 1024.f) + EPS);
#pragma unroll
          for (int j = 0; j < 4; ++j) { const int c = 4 * lane + 256 * j; const f32x4 w = *(const GAS f32x4*)(mlg + c); const f32x4 y = g[j] * w * rs;
              v2u o; o.x = pk2(y.x, y.y); o.y = pk2(y.z, y.w); *(GAS v2u*)(mix + c) = o; } }
#pragma unroll
        for (int j = 0; j < 4; ++j) { const int c = 4 * lane + 256 * j; f32x4 a1, a2;
            if (r < MP) { a1 = *(const GAS f32x4*)((const float*)(F.ws + WS_ATTO) + (size_t)r * 1024 + c); a2 = *(const GAS f32x4*)((const float*)(F.ws + WS_ATTO) + ((size_t)MT + r) * 1024 + c); }
            else { const int rs_ = r - MP; const float* SA = (const float*)(F.ws + WS_SATT); const float* ML = (const float*)(F.ws + WS_SML);
                f32x4 res[2];
#pragma unroll
                for (int s = 0; s < 2; ++s) { const float* mla = ML + (((size_t)(0 * 2 + s) * MS + rs_) * 4 + j) * 2; const float* mlb = ML + (((size_t)(1 * 2 + s) * MS + rs_) * 4 + j) * 2;
                    const float ma = mla[0], la = mla[1], mb = mlb[0], lb = mlb[1], m = fmaxf(ma, mb), wa = __builtin_amdgcn_exp2f((ma - m) * C), wb = __builtin_amdgcn_exp2f((mb - m) * C);
                    const float inv = 1.f / (wa * la + wb * lb);
                    const f32x4 oa = *(const GAS f32x4*)(SA + ((size_t)(0 * 2 + s) * MS + rs_) * 1024 + c), ob = *(const GAS f32x4*)(SA + ((size_t)(1 * 2 + s) * MS + rs_) * 1024 + c);
                    res[s] = (oa * wa + ob * wb) * inv; }
                a1 = res[0]; a2 = res[1]; }
            const f32x4 d = a1 - a2 * lam;
            const float ss = wave_sum((d.x * d.x + d.y * d.y) + (d.z * d.z + d.w * d.w));
            const float rs = oml * __builtin_amdgcn_rsqf(ss * (1.f / 256.f) + EPS);
            const f32x4 w = *(const GAS f32x4*)(dag + 4 * lane); const f32x4 y = d * w * rs;
            v2u o; o.x = pk2(y.x, y.y); o.y = pk2(y.z, y.w); *(GAS v2u*)(mix + 1024 + c) = o; }
    }
}
}
namespace op {
constexpr int NPH = 14, NPHASES = 1 + DEPTH * NPH;
enum { PH_G1A = 0, PH_G1B, PH_ROW1, PH_WIN, PH_CONV, PH_ATT, PH_SCAN, PH_MLH, PH_COMB, PH_WOUT, PH_ROW2, PH_G2A, PH_G2B, PH_ROW3 };

typedef const Params __attribute__((address_space(4)))* KArgs;
#define PHASE_FN(name) __device__ __forceinline__ void name(LAS unsigned char* lds_, unsigned char* ws_, float* out_, KArgs Pk, int li, int vcu_, int G_)
#define PHASE_FRAME() int bid_ = blockIdx.x; asm volatile("" : "+s"(ws_), "+s"(out_), "+s"(Pk), "+s"(vcu_), "+s"(G_), "+s"(bid_)); Frame F; F.lds = lds_; F.tid = threadIdx.x; asm volatile("" : "+v"(F.tid)); F.lane = F.tid & 63; F.wave = __builtin_amdgcn_readfirstlane(F.tid >> 6); F.vcu = vcu_; F.G = G_; F.gw = vcu_ * NWAVES + F.wave; F.NGW = G_ * NWAVES; F.ws = ws_; F.out = out_; \
    const Params& P = *(const Params*)Pk
PHASE_FN(ph_p0) { PHASE_FRAME();
    p0_weights(F, P);
    for (int r = F.gw; r < MT; r += F.NGW) { const float* xs = r < MP ? P.in[I_XP] + (size_t)r * DM : P.in[I_XS] + (size_t)(r - MP) * DM;
        row_one<false, true, false>(F, xs, F.out + (size_t)r * DM, nullptr, nullptr, 0.f, P.in[I_F1PRE], (bf16*)(F.ws + WS_HN) + (size_t)r * DM, nullptr, nullptr, nullptr, nullptr); }
}
template <int WHICH> PHASE_FN(ph_gemm_a) { PHASE_FRAME();
    pg8::Gemm g{(const bf16*)(F.ws + WS_HN), (const bf16*)lw(F, li, WHICH ? LW_W2A : LW_W1A), MT, 2 * DFF, DM}; pg8::StaticOrder S; S.init(MT, 2 * DFF, F.G, bid_);
    pg8::EpiSwiGLU E{(bf16*)(F.ws + WS_ACT), DFF};
    pg8::gemm_phase<pg8::EpiSwiGLU, pg8::StaticOrder, true, true, DM>(F.lds + RING_OFF, g, S, E);
}
template <int WHICH> PHASE_FN(ph_gemm_d) { PHASE_FRAME();
    pg8::Gemm g{(const bf16*)(F.ws + WS_ACT), (const bf16*)lw(F, li, WHICH ? LW_W2D : LW_W1D), MT, DM, DFF}; pg8::StaticOrder S; S.init(MT, DM, F.G, bid_);
    pg8::EpiF32 E{(float*)(F.ws + WS_Y), DM};
    pg8::gemm_phase<pg8::EpiF32, pg8::StaticOrder, true, true, DFF>(F.lds + RING_OFF, g, S, E);
}
PHASE_FN(ph_row1) { PHASE_FRAME();
    for (int r = F.gw; r < MT; r += F.NGW)
        row_one<true, true, true>(F, F.out + (size_t)r * DM, F.out + (size_t)r * DM, (const float*)(F.ws + WS_Y) + (size_t)r * DM, P.in[I_F1POST] + li * DM, 0.5f, P.in[I_MXPRE] + li * DM,
                                  (bf16*)(F.ws + WS_HN) + (size_t)r * DM, (const float*)lw(F, li, LW_WG), P.in[I_BI] + li * 4, P.in[I_BF] + li * 4, (float*)(F.ws + WS_GATES) + (size_t)r * 8);
}
PHASE_FN(ph_win) { PHASE_FRAME();
    pg8::Gemm g{(const bf16*)(F.ws + WS_HN), (const bf16*)lw(F, li, LW_WIN), MT, 6144, DM}; pg8::StaticOrder S; S.init(MT, 6144, F.G, bid_);
    pg8::EpiWin E{F.ws, F.out, li};
    pg8::gemm_phase<pg8::EpiWin, pg8::StaticOrder, true, true, DM>(F.lds + RING_OFF, g, S, E);
}
PHASE_FN(ph_conv) { PHASE_FRAME(); conv_phase(F, P, li); }
PHASE_FN(ph_att) { PHASE_FRAME();
    for (int item = F.vcu; item < NCK * 4; item += F.G) mlstm_dc_item(F, P, li, item);
    if (F.vcu & 1) { for (int item = F.vcu; item < DEC_BATCH * 4 * 2; item += F.G) attn_sample_item(F, P, li, item); }
    for (int p = F.vcu; p < 256; p += F.G) attn_prompt_pair(F, p);
    if (!(F.vcu & 1)) { for (int item = F.vcu; item < DEC_BATCH * 4 * 2; item += F.G) attn_sample_item(F, P, li, item); }
}
PHASE_FN(ph_comb) { PHASE_FRAME(); comb_phase(F, P, li); }
PHASE_FN(ph_wout) { PHASE_FRAME();
    pg8::Gemm g{(const bf16*)(F.ws + WS_MIX), (const bf16*)lw(F, li, LW_WOUT), MT, DM, DM}; pg8::StaticOrder S; S.init(MT, DM, F.G, bid_);
    pg8::EpiF32 E{(float*)(F.ws + WS_Y), DM};
    pg8::gemm_phase<pg8::EpiF32, pg8::StaticOrder, true, true, DM>(F.lds + RING_OFF, g, S, E);
}
PHASE_FN(ph_row2) { PHASE_FRAME();
    for (int r = F.gw; r < MT; r += F.NGW)
        row_one<true, true, false>(F, F.out + (size_t)r * DM, F.out + (size_t)r * DM, (const float*)(F.ws + WS_Y) + (size_t)r * DM, P.in[I_MXPOST] + li * DM, 1.0f, P.in[I_F2PRE] + li * DM,
                                   (bf16*)(F.ws + WS_HN) + (size_t)r * DM, nullptr, nullptr, nullptr, nullptr);
}
PHASE_FN(ph_row3) { PHASE_FRAME();
    if (li + 1 < DEPTH) { for (int r = F.gw; r < MT; r += F.NGW)
        row_one<true, true, false>(F, F.out + (size_t)r * DM, F.out + (size_t)r * DM, (const float*)(F.ws + WS_Y) + (size_t)r * DM, P.in[I_F2POST] + li * DM, 0.5f, P.in[I_F1PRE] + (li + 1) * DM,
                                   (bf16*)(F.ws + WS_HN) + (size_t)r * DM, nullptr, nullptr, nullptr, nullptr); }
    else { for (int r = F.gw; r < MT; r += F.NGW)
        row_one<true, false, false>(F, F.out + (size_t)r * DM, F.out + (size_t)r * DM, (const float*)(F.ws + WS_Y) + (size_t)r * DM, P.in[I_F2POST] + li * DM, 0.5f, nullptr, nullptr, nullptr, nullptr, nullptr, nullptr); }
}
PHASE_FN(ph_scan) { PHASE_FRAME(); mlstm_scan_phase(F, P, li); }
PHASE_FN(ph_mlh) { PHASE_FRAME(); for (int item = F.vcu; item < NCK * 4; item += F.G) mlstm_h_item(F, P, li, item); }

#define LAYER_BODY(LI) do { constexpr int li = LI; constexpr int pb = 1 + li * NPH;\
        RUN(pb + PH_G1A, ph_gemm_a<0>);\
        RUN(pb + PH_G1B, ph_gemm_d<0>);\
        RUN(pb + PH_ROW1, ph_row1);\
        RUN(pb + PH_WIN, ph_win);\
        RUN(pb + PH_CONV, ph_conv);\
        RUN(pb + PH_ATT, ph_att);\
        RUN(pb + PH_SCAN, ph_scan);\
        RUN(pb + PH_MLH, ph_mlh);\
        RUN(pb + PH_COMB, ph_comb);\
        RUN(pb + PH_WOUT, ph_wout);\
        RUN(pb + PH_ROW2, ph_row2);\
        RUN(pb + PH_G2A, ph_gemm_a<1>);\
        RUN(pb + PH_G2B, ph_gemm_d<1>);\
        RUN(pb + PH_ROW3, ph_row3); } while (0)
__global__ void __launch_bounds__(NWAVES * 64, 2) k_main(Params P) {
    extern __shared__ __attribute__((aligned(16))) unsigned char lds[];
    LAS unsigned char* const L = (LAS unsigned char*)lds;
    const int tid = threadIdx.x, G = gridDim.x; int vcu; { const int bx = blockIdx.x; vcu = (G % 8 == 0) ? (bx % 8) * (G / 8) + bx / 8 : bx; }
    for (int u = tid; u < (LDS_BYTES - LDSCTL_OFF) / 4; u += NWAVES * 64) ((LAS unsigned*)(L + LDSCTL_OFF))[u] = 0u;
    __syncthreads();
    const int lo0 = P.ph_lo, hi0 = P.ph_hi;
    unsigned char* const ws = P.ws; float* const out = P.out;
    const KArgs Pk = (KArgs)__builtin_amdgcn_kernarg_segment_ptr();
    XcdBarrier bar; bar.bar = (unsigned*)(ws + WS_CTL) + CW_BAR; bar.x = 0; bar.st = nullptr;
    if (hi0 - lo0 > 1) bar = xcd_barrier_post((unsigned*)(ws + WS_CTL) + CW_BAR, (volatile LAS unsigned*)(L + MISC_OFF) + 8);
#define IN(k) (lo <= (k) && (k) < hi)
#define SEAM(k) do { if (IN(k) && IN((k) + 1)) xcd_barrier(bar); } while (0)
#define RUN(k, fn) do { int lo = lo0, hi = hi0; asm volatile("" : "+s"(lo), "+s"(hi)); if (IN(k)) { asm volatile("; PHASE_BEGIN " #fn); fn(L, ws, out, Pk, li, vcu, G); asm volatile("; PHASE_END " #fn); } SEAM(k); } while (0)
    { const int li = 0; RUN(0, ph_p0); }
    LAYER_BODY(0);
    LAYER_BODY(1);
#undef IN
#undef SEAM
#undef RUN
#undef LAYER_BODY
}

static int g_grid = 0;
inline bool setup() {
    if (g_grid == 0) {
        int dev = 0, cus = 0;
        if (hipGetDevice(&dev) != hipSuccess || hipDeviceGetAttribute(&cus, hipDeviceAttributeMultiprocessorCount, dev) != hipSuccess) { g_grid = -1; return false; }
        if (hipFuncSetAttribute((const void*)k_main, hipFuncAttributeMaxDynamicSharedMemorySize, LDS_BYTES) != hipSuccess) { g_grid = -1; return false; }
        int per_cu = 0; (void)hipOccupancyMaxActiveBlocksPerMultiprocessor(&per_cu, (const void*)k_main, NWAVES * 64, LDS_BYTES); (void)hipGetLastError();
        g_grid = cus;
    }
    return g_grid > 0;
}
inline void launch_range(const Inputs& in, float* out, unsigned char* ws, int lo, int hi, hipStream_t s) {
    Params p{}; for (int i = 0; i < N_INPUTS; ++i) p.in[i] = in.p[i]; p.out = out; p.ws = ws; p.ph_lo = lo; p.ph_hi = hi;
    hipLaunchKernelGGL(k_main, dim3(g_grid), dim3(NWAVES * 64), LDS_BYTES, s, p);
}
}
#ifndef MK_FUSED
#define MK_FUSED 1
#endif
extern "C" void kernel_launch(void* const* d_in, const int* in_sizes, int n_in, void* d_out, int out_size, void* d_ws, size_t ws_size, hipStream_t stream) {
    Inputs in; for (int i = 0; i < N_INPUTS; ++i) in.p[i] = (const float*)d_in[i];
    if (!op::setup()) return;
    if (out_size != (int)O_END || ws_size < op::WS_END3) { fprintf(stderr, "kernel_launch: unexpected sizes (out %d, ws %zu)\n", out_size, ws_size); return; }
    float* out = (float*)d_out; unsigned char* obase = (unsigned char*)d_ws;
    (void)hipMemsetAsync(obase, 0, op::CTL_ZERO_BYTES, stream);
#if MK_FUSED
    op::launch_range(in, out, obase, 0, op::NPHASES, stream);
#else
    for (int ph = 0; ph < op::NPHASES; ++ph) op::launch_range(in, out, obase, ph, ph + 1, stream);
#endif
}
```
